# Optimizing an MI355X kernel written in HIP

```python
import jax, jax.numpy as jnp
from jax import lax
import numpy as np

D_MODEL = 1024
BATCH = 8
SEQ = 2048
DEPTH = 2
DEC_BATCH = 128
DEC_SEQ = 4
PAST_LEN = 16384
PAGE_SIZE = 128

N_MEM = 256
D_CONV = D_MODEL // 2
CONV_K = 3
LRU_WIDTH = D_MODEL // 2
LRU_BLOCKS = 8
LRU_BLOCK = LRU_WIDTH // LRU_BLOCKS
LRU_CONV_K = 4
LRU_C = 8.0
ATT_HEADS = 4
ATT_HEAD_DIM = 128
ATT_WIDTH = ATT_HEADS * ATT_HEAD_DIM
N_BRANCH = 3
D_FF = 2816
IN_SPLITS = [D_CONV, D_CONV, D_CONV, LRU_WIDTH, LRU_WIDTH, ATT_WIDTH, N_BRANCH * D_MODEL]
IN_COLS = sum(IN_SPLITS)
IN_OFFSETS = [int(v) for v in np.cumsum(IN_SPLITS)[:-1]]
DN_ALPHA = (2.0 * DEPTH) ** 0.25
DN_BETA = (8.0 * DEPTH) ** -0.25
LN_EPS = 1e-5

kernel_name = "hybrid_conv_rglru_memattn_decoder_step"


def _layernorm(x, g, b):
    xf = x.astype(jnp.float32)
    mu = jnp.mean(xf, axis=-1, keepdims=True)
    var = jnp.mean(jnp.square(xf - mu), axis=-1, keepdims=True)
    y = (xf - mu) * lax.rsqrt(var + LN_EPS) * g.astype(jnp.float32) + b.astype(jnp.float32)
    return y.astype(x.dtype)


def _swiglu(x, wg, wu, wd):
    return (jax.nn.silu(x @ wg) * (x @ wu)) @ wd


def _causal_dwconv(u, buf, w):
    k = w.shape[0]
    t = u.shape[1]
    ext = jnp.concatenate([buf.astype(u.dtype), u], axis=1)
    y = ext[:, 0:t] * w[0]
    for j in range(1, k):
        y = y + ext[:, j:j + t] * w[j]
    return y, ext[:, t:]


def _block_diag(x, w):
    xs = x.reshape(x.shape[:-1] + (LRU_BLOCKS, LRU_BLOCK))
    return jnp.einsum('btnk,nkj->btnj', xs, w).reshape(x.shape)


def _lin_combine(c1, c2):
    a1, b1 = c1
    a2, b2 = c2
    return a1 * a2, a2 * b1 + b2


def _rg_lru(xc, h0, wa, ba, wx, bx, lam):
    r = jax.nn.sigmoid((_block_diag(xc, wa) + ba).astype(jnp.float32))
    i = jax.nn.sigmoid((_block_diag(xc, wx) + bx).astype(jnp.float32))
    log_a = -LRU_C * r * jax.nn.softplus(-lam.astype(jnp.float32))
    a = jnp.exp(log_a)
    b = jnp.sqrt(-jnp.expm1(2.0 * log_a)) * (i * xc.astype(jnp.float32))
    a_cum, b_cum = lax.associative_scan(_lin_combine, (a, b), axis=1)
    h = a_cum * h0.astype(jnp.float32)[:, None, :] + b_cum
    return h.astype(xc.dtype), h[:, -1].astype(h0.dtype)


def _mixer(x, k_mem, v_mem, conv_buf, lru_buf, h0, w_in, conv_w, conv_out,
           lru_conv_w, lru_conv_b, lru_wa, lru_ba, lru_wx, lru_bx, lru_lambda,
           lru_out, att_out, w_o):
    bsz, t, _ = x.shape
    z = x @ w_in
    cv, cb, cc, lx, lg, q, gl = jnp.split(z, IN_OFFSETS, axis=-1)
    u, new_conv = _causal_dwconv(cc * cv, conv_buf, conv_w)
    y_conv = (cb * u) @ conv_out
    xc, new_lru_buf = _causal_dwconv(lx, lru_buf, lru_conv_w)
    xc = xc + lru_conv_b
    h, h_last = _rg_lru(xc, h0, lru_wa, lru_ba, lru_wx, lru_bx, lru_lambda)
    y_lru = (h * jax.nn.gelu(lg)) @ lru_out
    qh = q.reshape(bsz, t, ATT_HEADS, ATT_HEAD_DIM)
    s = jnp.einsum('bthd,bmhd->bhtm', qh, k_mem).astype(jnp.float32) * (ATT_HEAD_DIM ** -0.5)
    p = jax.nn.softmax(s, axis=-1).astype(x.dtype)
    o = jnp.einsum('bhtm,bmhd->bthd', p, v_mem).reshape(bsz, t, ATT_WIDTH)
    y_att = o @ att_out
    g = jax.nn.sigmoid(gl).reshape(bsz, t, N_BRANCH, D_MODEL)
    merged = g[:, :, 0] * y_conv + g[:, :, 1] * y_lru + g[:, :, 2] * y_att
    return merged @ w_o, new_conv, new_lru_buf, h_last


def _layer(x, k_mem, v_mem, conv_buf, lru_buf, h0, W):
    (ln1_g, ln1_b, ln2_g, ln2_b, ln3_g, ln3_b,
     ffn1_wg, ffn1_wu, ffn1_wd, ffn2_wg, ffn2_wu, ffn2_wd,
     w_in, conv_w, conv_out, lru_conv_w, lru_conv_b, lru_wa, lru_ba, lru_wx, lru_bx,
     lru_lambda, lru_out, att_out, w_o) = W
    x = _layernorm(DN_ALPHA * x + 0.5 * _swiglu(x, ffn1_wg, ffn1_wu, ffn1_wd), ln1_g, ln1_b)
    m, new_conv, new_lru_buf, h_last = _mixer(
        x, k_mem, v_mem, conv_buf, lru_buf, h0, w_in, conv_w, conv_out,
        lru_conv_w, lru_conv_b, lru_wa, lru_ba, lru_wx, lru_bx, lru_lambda,
        lru_out, att_out, w_o)
    x = _layernorm(DN_ALPHA * x + m, ln2_g, ln2_b)
    x = _layernorm(DN_ALPHA * x + 0.5 * _swiglu(x, ffn2_wg, ffn2_wu, ffn2_wd), ln3_g, ln3_b)
    return x, new_conv, new_lru_buf, h_last


def setup_inputs(seed: int = 0) -> dict:
    key = jax.random.key(seed)
    ks = jax.random.split(key, 40)
    f32 = jnp.float32
    nrm = lambda k, shape, s: jax.random.normal(k, shape, f32) * s
    d = DEPTH
    u = jax.random.uniform(ks[0], (d, LRU_WIDTH), f32, 0.9, 0.999)
    a0 = u ** (1.0 / LRU_C)
    lru_lambda = jnp.log(a0) - jnp.log1p(-a0)
    return {
        "x_prompt": nrm(ks[1], (BATCH, SEQ, D_MODEL), 1.0),
        "x_sample": nrm(ks[2], (DEC_BATCH, DEC_SEQ, D_MODEL), 1.0),
        "cache_mem_k": nrm(ks[3], (d, DEC_BATCH, N_MEM, ATT_HEADS, ATT_HEAD_DIM), 1.0),
        "cache_mem_v": nrm(ks[4], (d, DEC_BATCH, N_MEM, ATT_HEADS, ATT_HEAD_DIM), DN_BETA),
        "state_conv": nrm(ks[5], (d, DEC_BATCH, CONV_K - 1, D_CONV), 1.0),
        "state_lru_conv": nrm(ks[6], (d, DEC_BATCH, LRU_CONV_K - 1, LRU_WIDTH), 1.0),
        "state_lru_h": nrm(ks[7], (d, DEC_BATCH, LRU_WIDTH), 0.5),
        "mem_prompt": nrm(ks[8], (BATCH, N_MEM, D_MODEL), 1.0),
        "ln1_g": 1.0 + nrm(ks[9], (d, D_MODEL), 0.02),
        "ln1_b": nrm(ks[10], (d, D_MODEL), 0.02),
        "ln2_g": 1.0 + nrm(ks[11], (d, D_MODEL), 0.02),
        "ln2_b": nrm(ks[12], (d, D_MODEL), 0.02),
        "ln3_g": 1.0 + nrm(ks[13], (d, D_MODEL), 0.02),
        "ln3_b": nrm(ks[14], (d, D_MODEL), 0.02),
        "ffn1_wg": nrm(ks[15], (d, D_MODEL, D_FF), D_MODEL ** -0.5),
        "ffn1_wu": nrm(ks[16], (d, D_MODEL, D_FF), D_MODEL ** -0.5),
        "ffn1_wd": nrm(ks[17], (d, D_FF, D_MODEL), DN_BETA * D_FF ** -0.5),
        "ffn2_wg": nrm(ks[18], (d, D_MODEL, D_FF), D_MODEL ** -0.5),
        "ffn2_wu": nrm(ks[19], (d, D_MODEL, D_FF), D_MODEL ** -0.5),
        "ffn2_wd": nrm(ks[20], (d, D_FF, D_MODEL), DN_BETA * D_FF ** -0.5),
        "w_in": nrm(ks[21], (d, D_MODEL, IN_COLS), D_MODEL ** -0.5),
        "conv_w": nrm(ks[22], (d, CONV_K, D_CONV), CONV_K ** -0.5),
        "conv_out": nrm(ks[23], (d, D_CONV, D_MODEL), DN_BETA * D_CONV ** -0.5),
        "lru_conv_w": nrm(ks[24], (d, LRU_CONV_K, LRU_WIDTH), LRU_CONV_K ** -0.5),
        "lru_conv_b": nrm(ks[25], (d, LRU_WIDTH), 0.02),
        "lru_wa": nrm(ks[26], (d, LRU_BLOCKS, LRU_BLOCK, LRU_BLOCK), LRU_BLOCK ** -0.5),
        "lru_ba": nrm(ks[27], (d, LRU_WIDTH), 0.02),
        "lru_wx": nrm(ks[28], (d, LRU_BLOCKS, LRU_BLOCK, LRU_BLOCK), LRU_BLOCK ** -0.5),
        "lru_bx": nrm(ks[29], (d, LRU_WIDTH), 0.02),
        "lru_lambda": lru_lambda,
        "lru_out": nrm(ks[30], (d, LRU_WIDTH, D_MODEL), DN_BETA * LRU_WIDTH ** -0.5),
        "w_k_mem": nrm(ks[31], (d, D_MODEL, ATT_WIDTH), D_MODEL ** -0.5),
        "w_v_mem": nrm(ks[32], (d, D_MODEL, ATT_WIDTH), DN_BETA * D_MODEL ** -0.5),
        "att_out": nrm(ks[33], (d, ATT_WIDTH, D_MODEL), DN_BETA * ATT_WIDTH ** -0.5),
        "w_o": nrm(ks[34], (d, D_MODEL, D_MODEL), DN_BETA * D_MODEL ** -0.5),
    }


def reference(x_prompt, x_sample, cache_mem_k, cache_mem_v, state_conv, state_lru_conv,
              state_lru_h, mem_prompt, ln1_g, ln1_b, ln2_g, ln2_b, ln3_g, ln3_b,
              ffn1_wg, ffn1_wu, ffn1_wd, ffn2_wg, ffn2_wu, ffn2_wd, w_in, conv_w,
              conv_out, lru_conv_w, lru_conv_b, lru_wa, lru_ba, lru_wx, lru_bx,
              lru_lambda, lru_out, w_k_mem, w_v_mem, att_out, w_o):
    dt = x_prompt.dtype
    bp = x_prompt.shape[0]
    weights = (ln1_g, ln1_b, ln2_g, ln2_b, ln3_g, ln3_b,
               ffn1_wg, ffn1_wu, ffn1_wd, ffn2_wg, ffn2_wu, ffn2_wd,
               w_in, conv_w, conv_out, lru_conv_w, lru_conv_b, lru_wa, lru_ba, lru_wx, lru_bx,
               lru_lambda, lru_out, att_out, w_o)
    xp = x_prompt
    xs = x_sample
    p_k, p_v, p_conv, p_lconv, p_h = [], [], [], [], []
    s_conv, s_lconv, s_h = [], [], []
    for l in range(DEPTH):
        W = tuple(w[l] for w in weights)
        k_mem = (mem_prompt @ w_k_mem[l]).reshape(bp, N_MEM, ATT_HEADS, ATT_HEAD_DIM)
        v_mem = (mem_prompt @ w_v_mem[l]).reshape(bp, N_MEM, ATT_HEADS, ATT_HEAD_DIM)
        conv0 = jnp.zeros((bp, CONV_K - 1, D_CONV), dt)
        lconv0 = jnp.zeros((bp, LRU_CONV_K - 1, LRU_WIDTH), dt)
        h0 = jnp.zeros((bp, LRU_WIDTH), dt)
        xp, nc, nl, nh = _layer(xp, k_mem, v_mem, conv0, lconv0, h0, W)
        p_k.append(k_mem)
        p_v.append(v_mem)
        p_conv.append(nc)
        p_lconv.append(nl)
        p_h.append(nh)
        xs, sc, sl, sh = _layer(xs, cache_mem_k[l], cache_mem_v[l], state_conv[l],
                                state_lru_conv[l], state_lru_h[l], W)
        s_conv.append(sc)
        s_lconv.append(sl)
        s_h.append(sh)
    return (xp, xs,
            jnp.stack(p_k), jnp.stack(p_v), jnp.stack(p_conv), jnp.stack(p_lconv), jnp.stack(p_h),
            jnp.stack(s_conv), jnp.stack(s_lconv), jnp.stack(s_h))
```

```cpp
#include <hip/hip_runtime.h>
#include <hip/hip_cooperative_groups.h>
#include <cstdio>
namespace cg = cooperative_groups;

#define LAS __attribute__((address_space(3)))
typedef unsigned short bf16_t;
typedef short bf16x8 __attribute__((ext_vector_type(8)));
typedef float f32x4 __attribute__((ext_vector_type(4)));
typedef unsigned u32x4 __attribute__((ext_vector_type(4)));
typedef unsigned u32x2 __attribute__((ext_vector_type(2)));

constexpr int TP = 16384, TS = 512, T = TP + TS, D = 1024, FF = 2816, NIN = 6144, CW = 512;
constexpr int ZC_CV = 0, ZC_CB = 512, ZC_CC = 1024, ZC_LX = 1536, ZC_LG = 2048, ZC_Q = 2560, ZC_GL = 3072;
constexpr float ALPHA = 1.41421356237309515f, LN_EPS = 1e-5f;
constexpr int LDS_BYTES = 147456;
constexpr size_t O_Y = 0, O_PK = 17301504, O_PV = 19398656, O_PCONV = 21495808, O_PLCONV = 21512192, O_PH = 21536768,
                 O_SCONV = 21544960, O_SLCONV = 21807104, O_SH = 22200320;
constexpr size_t SZ_WGU = (size_t)2 * FF * D * 2, SZ_WD = (size_t)D * FF * 2, SZ_WIN = (size_t)NIN * D * 2, SZ_WBR = (size_t)D * CW * 2,
                 SZ_WO = (size_t)D * D * 2, SZ_LRUW = (size_t)64 * 512 * 2;
constexpr size_t WL_GU1 = 0, WL_D1 = WL_GU1 + SZ_WGU, WL_GU2 = WL_D1 + SZ_WD, WL_D2 = WL_GU2 + SZ_WGU, WL_IN = WL_D2 + SZ_WD,
                 WL_BR = WL_IN + SZ_WIN, WL_O = WL_BR + 3 * SZ_WBR, WL_LWA = WL_O + SZ_WO, WL_LWX = WL_LWA + SZ_LRUW, WL_SIZE = WL_LWX + SZ_LRUW;
constexpr size_t MiB = 1u << 20;
constexpr size_t WS_W = 1 * MiB, WS_WKV = WS_W + 2 * WL_SIZE, WS_MEMB = WS_WKV + 4 * MiB, WS_KMEM = WS_MEMB + 4 * MiB, WS_VT = WS_KMEM + 4 * MiB,
                 WS_XB = WS_VT + 4 * MiB, WS_HZ = WS_XB + (size_t)T * D * 2, WS_YBR = WS_HZ + (size_t)T * NIN * 2,
                 WS_ACUM = WS_YBR + 3 * (size_t)T * CW * 2, WS_BCUM = WS_ACUM + (size_t)T * CW * 4, WS_AGG = WS_BCUM + (size_t)T * CW * 4,
                 WS_MRG = WS_AGG + (size_t)132 * 512 * 2 * 4, WS_END = WS_MRG + (size_t)T * D * 2;
static_assert(WS_END < 565ull * 1000 * 1000, "workspace budget");
constexpr size_t WS_SLB3 = WS_ACUM + (size_t)T * CW * 2;
static_assert(WS_SLB3 + 3 * (size_t)TS * D * 4 <= WS_BCUM, "sample branch slabs fit behind the bf16 cumulants");

constexpr int CW_CNT = 4096, CW_WORDS = 4096 + 6 * 64 * 64;
constexpr size_t WS_XCH = 512 * 1024;
struct Params { const float* in[35]; float* out; unsigned char* ws; };
typedef const __attribute__((address_space(4))) Params* CP;
__device__ __forceinline__ CP kp() { CP q = (CP)__builtin_amdgcn_kernarg_segment_ptr(); asm volatile("" : "+s"(q)); return q; }
__device__ __forceinline__ int tid_() { int t = threadIdx.x; asm volatile("" : "+v"(t)); return t; }

__device__ __forceinline__ unsigned cvt_pk_bf16(float lo, float hi) { unsigned r; asm("v_cvt_pk_bf16_f32 %0, %1, %2" : "=v"(r) : "v"(lo), "v"(hi)); return r; }
__device__ __forceinline__ float bf_lo(unsigned u) { return __uint_as_float(u << 16); }
__device__ __forceinline__ float bf_hi(unsigned u) { return __uint_as_float(u & 0xffff0000u); }
__device__ __forceinline__ float bf2f(bf16_t b) { return __uint_as_float(((unsigned)b) << 16); }
__device__ __forceinline__ float sigmoidf_(float x) { return __builtin_amdgcn_rcpf(1.0f + __expf(-x)); }
__device__ __forceinline__ float silu_(float x) { return x * sigmoidf_(x); }
__device__ __forceinline__ float one_minus_exp_(float x) {
    const float ser = -x * (1.0f + x * (0.5f + x * (0.16666667f + x * (0.041666668f + x * (0.0083333338f + x * 0.0013888889f)))));
    return x > -0.25f ? ser : 1.0f - __expf(x);
}
__device__ __forceinline__ float softplus_neg_(float lam) {
    const float y = __expf(-lam);
    const float ser = y * (1.0f - y * (0.5f - y * (0.33333334f - y * 0.25f)));
    return y < 0.03f ? ser : __logf(1.0f + y);
}
__device__ __forceinline__ float gelu_tanh_(float x) { return x * sigmoidf_(1.5957691216057308f * (x + 0.044715f * x * x * x)); }
__device__ __forceinline__ float wave_sum(float v) {
#pragma unroll
    for (int o = 1; o < 64; o <<= 1) v += __shfl_xor(v, o);
    return v;
}
__device__ __forceinline__ float wave_max(float v) {
#pragma unroll
    for (int o = 1; o < 64; o <<= 1) v = fmaxf(v, __shfl_xor(v, o));
    return v;
}
__device__ __forceinline__ void unpack8(const u32x4 v, float (&f)[8]) {
    f[0] = bf_lo(v.x); f[1] = bf_hi(v.x); f[2] = bf_lo(v.y); f[3] = bf_hi(v.y); f[4] = bf_lo(v.z); f[5] = bf_hi(v.z); f[6] = bf_lo(v.w); f[7] = bf_hi(v.w);
}

namespace pg8 {
constexpr int BM = 256, BK = 64, HALF = 128, HTB = HALF * BK * 2, STAGE_BYTES = 8 * HTB, NXCD = 8, WGM = 8;
__device__ __forceinline__ int lds_byte(int r, int c) { const int st = (r >> 4) * 2 + (c >> 5), rr = r & 15, cc = c & 31, ob = rr * 64 + cc * 2; return st * 1024 + (ob ^ (((ob >> 9) & 1) << 5)); }
__device__ __forceinline__ void stage_rc(int b, int& R, int& C) { const int st = b / 1024, sb = b % 1024, swz = sb ^ (((sb >> 9) & 1) << 5); R = (st >> 1) * 16 + swz / 64; C = (st & 1) * 32 + (swz % 64) / 2; }
__device__ __forceinline__ int perm32(int rho) { const int n = rho >> 4, i = rho & 15; return 8 * (i >> 2) + 4 * n + (i & 3); }
struct Unit { int pm, pn, k0, nkt; };
struct Gemm { const bf16_t* A; const bf16_t* Bt; int M, N, K; };
struct StaticOrder {
    int nM, nN, nwg, G, c, kt;
    __device__ __forceinline__ void init(int M, int N, int K, int G_, int c_) { nM = M / BM; nN = N / BM; nwg = nM * nN; G = G_; c = c_; kt = K / BK; }
    __device__ __forceinline__ bool next(int i, int& pm, int& pn, int& k0, int& nkt) const {
        const int L = i * G + c; k0 = 0; nkt = kt; pm = 0; pn = 0;
        if (L >= nwg) return false;
        int wgid = L; { const int q = nwg / NXCD, r = nwg % NXCD, xcd = wgid % NXCD, off = wgid / NXCD; wgid = (xcd < r ? xcd * (q + 1) : r * (q + 1) + (xcd - r) * q) + off; }
        const int nig = WGM * nN, gid = wgid / nig, fm = gid * WGM, gsz = (nM - fm) < WGM ? (nM - fm) : WGM;
        pm = fm + ((wgid % nig) % gsz); pn = (wgid % nig) / gsz; return true;
    }
};

struct TailOrder {
    StaticOrder P; int nsplit, ktm, nmini;
    __device__ __forceinline__ void init(int N, int K, int G_, int c_, int nsplit_) { P.init(16384, N, K, G_, c_); nsplit = nsplit_; ktm = (K / BK) / nsplit_; nmini = 2 * P.nN * nsplit_; }
    __device__ __forceinline__ bool next(int i, int& pm, int& pn, int& k0, int& nkt) const {
        const bool has_mini = P.c < nmini;
        if (has_mini && i == 0) { const int j = P.c, tile = j / nsplit, sp = j - tile * nsplit;
            pm = 64 + tile / P.nN; pn = tile % P.nN; k0 = sp * ktm; nkt = ktm; return true; }
        const int ip = has_mini ? i - 1 : i;
        const bool ok = P.next(0, pm, pn, k0, nkt);
        return ok && ip == 0;
    }
};

struct ChainOrder {
    StaticOrder P; int segk, sc;
    __device__ __forceinline__ void init(int M, int N, int K, int G_, int c_, int sc_) { P.init(M, N, K, G_, c_); segk = (K / BK) / 3; sc = sc_; }
    __device__ __forceinline__ bool next(int i, int& pm, int& pn, int& k0, int& nkt) const {
        const int r = i / 3, sg = i - 3 * r; int d0, d1;
        bool ok = P.next(r, pm, pn, d0, d1);
        k0 = sg * segk; nkt = segk;
        if (sc >= 0) { const int tile = sc / 3; pm = 64 + (tile >> 2); pn = tile & 3; k0 = (sc - 3 * tile) * segk; ok = (i == 0); }
        return ok;
    }
};

template <class Epi, class Sched>
__device__ __forceinline__ void gemm_phase(LAS unsigned char* lds, const Gemm g, const Sched& S, const Epi& E) {
    const int tid = tid_(), wid = __builtin_amdgcn_readfirstlane(tid >> 6), lane = tid & 63, wr = wid >> 2, wc = wid & 3, fr = lane & 15, fq = lane >> 4;
    const int K = g.K;
    unsigned voffA[2], voffB[2];
#pragma unroll
    for (int i = 0; i < 2; ++i) { int R, C; stage_rc(tid * 16 + i * 8192, R, C); const int Rb = Epi::PERM ? ((R & ~31) + perm32(R & 31)) : R;
        voffA[i] = (unsigned)(R * K + C) * 2u; voffB[i] = (unsigned)(Rb * K + C) * 2u; }
    const size_t kstep = (size_t)(BK * 2);
    const size_t hstep = (size_t)HALF * K * 2;
    const size_t tstep = 2 * hstep;
    const unsigned ldsw = (unsigned)wid * 1024u;
    const int aoff = lds_byte(wr * 64 + fr, fq * 8), boff = lds_byte(wc * 32 + fr, fq * 8);
#define PG8_SA(b, h) (((b) * 2 + (h)) * HTB)
#define PG8_SB(b, h) ((4 + (b) * 2 + (h)) * HTB)
#define PG8_STAGE(bufoff, gbase, voff) do { _Pragma("unroll") for (int _i = 0; _i < 2; ++_i) \
        __builtin_amdgcn_global_load_lds((const unsigned*)((const char*)(gbase) + (voff)[_i]), (LAS unsigned*)(lds + (bufoff) + ldsw + _i * 8192), 16, 0, 0); } while (0)
#define PG8_LDA(dst, b, h) do { _Pragma("unroll") for (int m = 0; m < 4; ++m) _Pragma("unroll") for (int k = 0; k < 2; ++k) dst[m][k] = *(const LAS bf16x8*)(lds + PG8_SA(b, h) + aoff + m * 2048 + k * 1024); } while (0)
#define PG8_LDB(dst, b, h) do { _Pragma("unroll") for (int n = 0; n < 2; ++n) _Pragma("unroll") for (int k = 0; k < 2; ++k) dst[n][k] = *(const LAS bf16x8*)(lds + PG8_SB(b, h) + boff + n * 2048 + k * 1024); } while (0)
#define PG8_MMA(ai, bj, At, Bt) do { __builtin_amdgcn_s_setprio(1); _Pragma("unroll") for (int m = 0; m < 4; ++m) _Pragma("unroll") for (int n = 0; n < 2; ++n) _Pragma("unroll") for (int k = 0; k < 2; ++k) \
        acc[ai][bj][m][n] = __builtin_amdgcn_mfma_f32_16x16x32_bf16(Bt[n][k], At[m][k], acc[ai][bj][m][n], 0, 0, 0); __builtin_amdgcn_s_setprio(0); } while (0)
#define PG8_WAIT_V(n) asm volatile("s_waitcnt vmcnt(" #n ")" ::: "memory")
#define PG8_WAIT_L(n) asm volatile("s_waitcnt lgkmcnt(" #n ")" ::: "memory")
#define PG8_BAR __builtin_amdgcn_s_barrier()
#define PG8_SCHED __builtin_amdgcn_sched_barrier(0)
    int cpm, cpn, ck0, cnk, npm, npn, nk0, nnk; int ui = 0;
    if (!S.next(0, cpm, cpn, ck0, cnk)) return;
    f32x4 acc[2][2][4][2];
#pragma unroll
    for (int a = 0; a < 2; ++a)
#pragma unroll
        for (int b = 0; b < 2; ++b)
#pragma unroll
            for (int m = 0; m < 4; ++m)
#pragma unroll
                for (int n = 0; n < 2; ++n) acc[a][b][m][n] = (f32x4){0.f, 0.f, 0.f, 0.f};
    bf16x8 At[4][2], B0[2][2], B1[2][2];
    const char* cA = (const char*)g.A + (size_t)cpm * tstep + (size_t)ck0 * kstep; const char* cB = (const char*)g.Bt + (size_t)cpn * tstep + (size_t)ck0 * kstep;
    PG8_STAGE(PG8_SB(0, 0), cB, voffB); PG8_STAGE(PG8_SA(0, 0), cA, voffA); PG8_STAGE(PG8_SB(0, 1), cB + hstep, voffB); PG8_STAGE(PG8_SA(0, 1), cA + hstep, voffA);
    if (wr == 1) PG8_BAR;
    PG8_WAIT_V(4); PG8_BAR;
    PG8_STAGE(PG8_SB(1, 0), cB + kstep, voffB); PG8_STAGE(PG8_SA(1, 0), cA + kstep, voffA); PG8_STAGE(PG8_SB(1, 1), cB + hstep + kstep, voffB);
    PG8_WAIT_V(6); PG8_BAR;
    for (;;) {
        const bool has_next = S.next(ui + 1, npm, npn, nk0, nnk);
        const char* nA = has_next ? (const char*)g.A + (size_t)npm * tstep + (size_t)nk0 * kstep : cA; const char* nB = has_next ? (const char*)g.Bt + (size_t)npn * tstep + (size_t)nk0 * kstep : cB;
        const int nt = cnk;
        for (int t = 0; t < nt; t += 2) {
            const bool last = (t == nt - 2);
            const char* a1 = cA + (size_t)(t + 1) * kstep;
            const char* a2 = last ? nA : cA + (size_t)(t + 2) * kstep; const char* b2 = last ? nB : cB + (size_t)(t + 2) * kstep;
            const char* a3 = a2 + kstep; const char* b3 = b2 + kstep;
            PG8_LDB(B0, 0, 0); PG8_SCHED; PG8_LDA(At, 0, 0); PG8_STAGE(PG8_SA(1, 1), a1 + hstep, voffA);
            PG8_WAIT_L(8); PG8_BAR; PG8_WAIT_L(0); PG8_MMA(0, 0, At, B0); PG8_BAR; PG8_SCHED;
            PG8_LDB(B1, 0, 1); PG8_STAGE(PG8_SB(0, 0), b2, voffB);
            PG8_BAR; PG8_WAIT_L(0); PG8_MMA(0, 1, At, B1); PG8_BAR;
            PG8_LDA(At, 0, 1); PG8_STAGE(PG8_SA(0, 0), a2, voffA);
            PG8_BAR; PG8_WAIT_L(0); PG8_MMA(1, 0, At, B0); PG8_BAR; PG8_SCHED;
            PG8_STAGE(PG8_SB(0, 1), b2 + hstep, voffB);
            PG8_WAIT_V(6); PG8_BAR; PG8_MMA(1, 1, At, B1); PG8_BAR;
            PG8_LDB(B0, 1, 0); PG8_SCHED; PG8_LDA(At, 1, 0); PG8_STAGE(PG8_SA(0, 1), a2 + hstep, voffA);
            PG8_WAIT_L(8); PG8_BAR; PG8_WAIT_L(0); PG8_MMA(0, 0, At, B0); PG8_BAR; PG8_SCHED;
            PG8_LDB(B1, 1, 1); PG8_STAGE(PG8_SB(1, 0), b3, voffB);
            PG8_BAR; PG8_WAIT_L(0); PG8_MMA(0, 1, At, B1); PG8_BAR;
            PG8_LDA(At, 1, 1); PG8_STAGE(PG8_SA(1, 0), a3, voffA);
            PG8_BAR; PG8_WAIT_L(0); PG8_MMA(1, 0, At, B0); PG8_BAR; PG8_SCHED;
            PG8_STAGE(PG8_SB(1, 1), b3 + hstep, voffB);
            PG8_WAIT_V(6); PG8_BAR; PG8_MMA(1, 1, At, B1); PG8_BAR;
        }
        if (has_next || !Epi::AFTER_DRAIN) { Unit cu; cu.pm = cpm; cu.pn = cpn; cu.k0 = ck0; cu.nkt = cnk; E(acc, cu, wr, wc, fr, fq); }
        if (!has_next) break;
        if (!(Epi::CHAIN && nk0 != 0)) {
#pragma unroll
        for (int a = 0; a < 2; ++a)
#pragma unroll
            for (int b = 0; b < 2; ++b)
#pragma unroll
                for (int m = 0; m < 4; ++m)
#pragma unroll
                    for (int n = 0; n < 2; ++n) acc[a][b][m][n] = (f32x4){0.f, 0.f, 0.f, 0.f};
        }
        cpm = npm; cpn = npn; ck0 = nk0; cnk = nnk; cA = nA; cB = nB; ++ui;
    }
    PG8_WAIT_V(0);
    if (wr == 0) PG8_BAR;
    PG8_BAR;
    if constexpr (Epi::AFTER_DRAIN) E.fused(acc, cpm, cpn, wr, wc, fr, fq, lds, wid, lane);
#undef PG8_SA
#undef PG8_SB
#undef PG8_STAGE
#undef PG8_LDA
#undef PG8_LDB
#undef PG8_MMA
#undef PG8_WAIT_V
#undef PG8_WAIT_L
#undef PG8_BAR
#undef PG8_SCHED
}
}
using pg8::Unit;
typedef f32x4 AccT[2][2][4][2];

struct EpiGU {
    static constexpr bool AFTER_DRAIN = false, CHAIN = false, PERM = true;
    bf16_t* H;
    __device__ __forceinline__ void operator()(AccT& acc, const Unit& u, int wr, int wc, int fr, int fq) const {
        const int row0 = u.pm * 256 + wr * 64 + fr, col0 = u.pn * 128 + wc * 32 + 8 * fq;
#pragma unroll
        for (int ai = 0; ai < 2; ++ai)
#pragma unroll
            for (int m = 0; m < 4; ++m) {
                bf16_t* rowp = H + (size_t)(row0 + ai * 128 + m * 16) * FF + col0;
                const f32x4 g0 = acc[ai][0][m][0], g1 = acc[ai][0][m][1], u0 = acc[ai][1][m][0], u1 = acc[ai][1][m][1];
                u32x4 w;
                w.x = cvt_pk_bf16(silu_(g0[0]) * u0[0], silu_(g0[1]) * u0[1]); w.y = cvt_pk_bf16(silu_(g0[2]) * u0[2], silu_(g0[3]) * u0[3]);
                w.z = cvt_pk_bf16(silu_(g1[0]) * u1[0], silu_(g1[1]) * u1[1]); w.w = cvt_pk_bf16(silu_(g1[2]) * u1[2], silu_(g1[3]) * u1[3]);
                *(u32x4*)rowp = w;
            }
    }
};
__device__ __forceinline__ void panel_stats_run(unsigned* xbuf, unsigned* cnt, const AccT& v, const int upm, const int upn, int wr, int wc, int fr, int fq, LAS unsigned char* lds, int wid, int lane) {
    {
        typedef float f32x2v __attribute__((ext_vector_type(2)));
        LAS f32x2v* Pt = (LAS f32x2v*)lds;
        LAS f32x2v* St = (LAS f32x2v*)(lds + 8192);
#pragma unroll
        for (int ai = 0; ai < 2; ++ai)
#pragma unroll
            for (int m = 0; m < 4; ++m) {
                float s = 0.f;
#pragma unroll
                for (int bj = 0; bj < 2; ++bj)
#pragma unroll
                    for (int n = 0; n < 2; ++n) { const f32x4 x = v[ai][bj][m][n]; s += (x[0] + x[1]) + (x[2] + x[3]); }
                s += __shfl_xor(s, 16); s += __shfl_xor(s, 32);
                const float mw = s * (1.0f / 64.0f); float q = 0.f;
#pragma unroll
                for (int bj = 0; bj < 2; ++bj)
#pragma unroll
                    for (int n = 0; n < 2; ++n) { const f32x4 d = v[ai][bj][m][n] - mw; q += (d[0] * d[0] + d[1] * d[1]) + (d[2] * d[2] + d[3] * d[3]); }
                q += __shfl_xor(q, 16); q += __shfl_xor(q, 32);
                if (fq == 0) Pt[(ai * 128 + wr * 64 + m * 16 + fr) * 4 + wc] = (f32x2v){mw, q};
                __builtin_amdgcn_sched_barrier(0);
            }
        asm volatile("s_waitcnt lgkmcnt(0)" ::: "memory"); __builtin_amdgcn_s_barrier(); asm volatile("" ::: "memory");
        const int row = wid * 32 + (lane & 31);
        if (lane < 32) {
            const f32x2v a = Pt[row * 4 + 0], b = Pt[row * 4 + 1], c = Pt[row * 4 + 2], d = Pt[row * 4 + 3];
            const float mt = (a.x + b.x + c.x + d.x) * 0.25f;
            const float da = a.x - mt, db = b.x - mt, dc = c.x - mt, dd = d.x - mt;
            const float m2 = (a.y + b.y) + (c.y + d.y) + 64.0f * ((da * da + db * db) + (dc * dc + dd * dd));
            unsigned long long* slot = (unsigned long long*)xbuf + ((size_t)(upm * 256 + row) * 4 + upn);
            __hip_atomic_store(slot, ((unsigned long long)__float_as_uint(m2) << 32) | __float_as_uint(mt), __ATOMIC_RELAXED, __HIP_MEMORY_SCOPE_AGENT);
        }
        asm volatile("s_waitcnt vmcnt(0)" ::: "memory");
        if (lane == 0) __hip_atomic_fetch_add(cnt + 64 * upm, 1u, __ATOMIC_RELAXED, __HIP_MEMORY_SCOPE_AGENT);
        if (wid == 0) {
            unsigned sp = 0;
            while ((unsigned)__builtin_amdgcn_readfirstlane(__hip_atomic_load(cnt + 64 * upm, __ATOMIC_RELAXED, __HIP_MEMORY_SCOPE_AGENT)) < 32u) {
                __builtin_amdgcn_s_sleep(2); if (++sp > (1u << 22)) break; }
            __builtin_amdgcn_fence(__ATOMIC_ACQUIRE, "agent");
        }
        asm volatile("s_waitcnt vmcnt(0) lgkmcnt(0)" ::: "memory"); __builtin_amdgcn_s_barrier(); asm volatile("" ::: "memory");
        if (lane < 32) {
            const unsigned long long* slot = (const unsigned long long*)xbuf + (size_t)(upm * 256 + row) * 4; float mt[4], m2[4]; float ms = 0.f;
#pragma unroll
            for (int t = 0; t < 4; ++t) { const unsigned long long w = __hip_atomic_load(slot + t, __ATOMIC_RELAXED, __HIP_MEMORY_SCOPE_AGENT); mt[t] = __uint_as_float((unsigned)w); m2[t] = __uint_as_float((unsigned)(w >> 32)); ms += mt[t]; }
            const float mean = ms * 0.25f; float q = 0.f;
#pragma unroll
            for (int t = 0; t < 4; ++t) { const float dm = mt[t] - mean; q += m2[t] + 256.0f * dm * dm; }
            St[row] = (f32x2v){mean, 1.0f / sqrtf(q * (1.0f / 1024.0f) + LN_EPS)};
        }
        asm volatile("s_waitcnt lgkmcnt(0)" ::: "memory"); __builtin_amdgcn_s_barrier(); asm volatile("" ::: "memory");
    }
}
template <bool HALF> struct EpiRes {
    static constexpr bool CHAIN = false, PERM = true, AFTER_DRAIN = true;
    static constexpr float scale = HALF ? 0.5f : 1.0f;
    float* Xout; float* slab; const float* lng; const float* lnb; unsigned* cnt; int nmini;
    __device__ __forceinline__ void operator()(AccT& acc, const Unit& u, int wr, int wc, int fr, int fq) const {
        const int row0 = u.pm * 256 + wr * 64 + fr, col0 = u.pn * 256 + wc * 32 + 8 * fq;
        const int sp = u.k0 / u.nkt;
        float* base = slab + ((size_t)sp * TS + (row0 - TP)) * D + col0;
#pragma unroll
        for (int ai = 0; ai < 2; ++ai)
#pragma unroll
            for (int m = 0; m < 4; ++m)
#pragma unroll
                for (int bj = 0; bj < 2; ++bj) { float* pp = base + (size_t)(ai * 128 + m * 16) * D + bj * 128;
                    *(f32x4*)pp = acc[ai][bj][m][0] * scale; *(f32x4*)(pp + 4) = acc[ai][bj][m][1] * scale; }
    }
    __device__ __forceinline__ void fused(AccT& acc, const int upm, const int upn, int, int, int, int, LAS unsigned char* lds, int, int) const {
        typedef float f32x2v __attribute__((ext_vector_type(2)));
        const int tid2 = tid_(), wid = __builtin_amdgcn_readfirstlane(tid2 >> 6), lane = tid2 & 63, wr = wid >> 2, wc = wid & 3, fr = lane & 15, fq = lane >> 4;
        const int row0 = upm * 256 + wr * 64 + fr, col0 = upn * 256 + wc * 32 + 8 * fq;
        bf16_t* XB = (bf16_t*)((unsigned char*)slab - (WS_ACUM - WS_XB)); unsigned* xbuf = (unsigned*)((unsigned char*)slab - (WS_ACUM - WS_XCH));
        bf16_t* bb = XB + (size_t)row0 * D + col0;
        if (wid == 0) {
            if ((int)blockIdx.x < nmini) { __builtin_amdgcn_fence(__ATOMIC_RELEASE, "agent"); asm volatile("s_waitcnt vmcnt(0)" ::: "memory"); }
            if (lane == 0) __hip_atomic_fetch_add(cnt + 32, 1u, __ATOMIC_RELAXED, __HIP_MEMORY_SCOPE_AGENT);
        }
        {
            u32x4 v[2][4][2];
#pragma unroll
            for (int ai = 0; ai < 2; ++ai)
#pragma unroll
                for (int m = 0; m < 4; ++m)
#pragma unroll
                    for (int bj = 0; bj < 2; ++bj) v[ai][m][bj] = *(const u32x4*)(bb + (size_t)(ai * 128 + m * 16) * D + bj * 128);
#pragma unroll
            for (int ai = 0; ai < 2; ++ai) {
#pragma unroll
                for (int m = 0; m < 4; ++m)
#pragma unroll
                    for (int bj = 0; bj < 2; ++bj) { float x[8]; unpack8(v[ai][m][bj], x);
                        acc[ai][bj][m][0] = (f32x4){x[0], x[1], x[2], x[3]} * ALPHA + acc[ai][bj][m][0] * scale;
                        acc[ai][bj][m][1] = (f32x4){x[4], x[5], x[6], x[7]} * ALPHA + acc[ai][bj][m][1] * scale; }
#pragma unroll
                for (int m = 0; m < 4; ++m) asm volatile("" : "+v"(acc[ai][0][m][0]), "+v"(acc[ai][0][m][1]), "+v"(acc[ai][1][m][0]), "+v"(acc[ai][1][m][1]));
            }
            asm volatile("" ::: "memory");
        }
        panel_stats_run(xbuf, cnt, acc, upm, upn, wr, wc, fr, fq, lds, wid, lane);
        asm volatile("" ::: "memory");
        const LAS f32x2v* St = (const LAS f32x2v*)(lds + 8192);
        float* xo = Xout ? Xout + (size_t)row0 * D + col0 : nullptr;
        f32x4 gq[2][2], bq[2][2];
#pragma unroll
        for (int bj = 0; bj < 2; ++bj) { gq[bj][0] = *(const f32x4*)(lng + col0 + bj * 128); gq[bj][1] = *(const f32x4*)(lng + col0 + bj * 128 + 4);
            bq[bj][0] = *(const f32x4*)(lnb + col0 + bj * 128); bq[bj][1] = *(const f32x4*)(lnb + col0 + bj * 128 + 4); }
#pragma unroll
        for (int ai = 0; ai < 2; ++ai)
#pragma unroll
            for (int m = 0; m < 4; ++m) { const f32x2v sr = St[ai * 128 + wr * 64 + m * 16 + fr];
#pragma unroll
                for (int bj = 0; bj < 2; ++bj) { const size_t off = (size_t)(ai * 128 + m * 16) * D + bj * 128;
                    const f32x4 g0 = gq[bj][0], g1 = gq[bj][1], b0 = bq[bj][0], b1 = bq[bj][1];
                    const f32x4 y0 = (acc[ai][bj][m][0] - sr.x) * sr.y * g0 + b0, y1 = (acc[ai][bj][m][1] - sr.x) * sr.y * g1 + b1;
                    if (xo) { *(f32x4*)(xo + off) = y0; *(f32x4*)(xo + off + 4) = y1; }
                    u32x4 w; w.x = cvt_pk_bf16(y0[0], y0[1]); w.y = cvt_pk_bf16(y0[2], y0[3]); w.z = cvt_pk_bf16(y1[0], y1[1]); w.w = cvt_pk_bf16(y1[2], y1[3]); *(u32x4*)(bb + off) = w; }
                asm volatile("" ::: "memory"); }
    }
};
struct EpiZ {
    static constexpr bool AFTER_DRAIN = false, CHAIN = false, PERM = true;
    bf16_t* Z;
    __device__ __forceinline__ void operator()(AccT& acc, const Unit& u, int wr, int wc, int fr, int fq) const {
        const int row0 = u.pm * 256 + wr * 64 + fr, col0 = u.pn * 256 + wc * 32 + 8 * fq;
        const int mode = (u.pn >= 12) ? 2 : ((u.pn == 8 || u.pn == 9) ? 1 : 0);
#pragma unroll
        for (int ai = 0; ai < 2; ++ai)
#pragma unroll
            for (int m = 0; m < 4; ++m) {
                bf16_t* rowp = Z + (size_t)(row0 + ai * 128 + m * 16) * NIN + col0;
#pragma unroll
                for (int bj = 0; bj < 2; ++bj) {
                    f32x4 v0 = acc[ai][bj][m][0], v1 = acc[ai][bj][m][1];
                    if (mode == 2) {
#pragma unroll
                        for (int j = 0; j < 4; ++j) { v0[j] = sigmoidf_(v0[j]); v1[j] = sigmoidf_(v1[j]); }
                    } else if (mode == 1) {
#pragma unroll
                        for (int j = 0; j < 4; ++j) { v0[j] = gelu_tanh_(v0[j]); v1[j] = gelu_tanh_(v1[j]); }
                    }
                    u32x4 w; w.x = cvt_pk_bf16(v0[0], v0[1]); w.y = cvt_pk_bf16(v0[2], v0[3]); w.z = cvt_pk_bf16(v1[0], v1[1]); w.w = cvt_pk_bf16(v1[2], v1[3]);
                    *(u32x4*)(rowp + bj * 128) = w;
                }
            }
    }
};
struct EpiKV {
    static constexpr bool AFTER_DRAIN = false, CHAIN = false, PERM = false;
    float* out; bf16_t* KM; bf16_t* VT;
    __device__ __forceinline__ void operator()(AccT& acc, const Unit& u, int wr, int wc, int fr, int fq) const {
        const int l = u.pn >> 2, kv = (u.pn >> 1) & 1, half = u.pn & 1;
        float* ob = out + (kv ? O_PV : O_PK) + (size_t)l * 2048 * 512;
#pragma unroll
        for (int ai = 0; ai < 2; ++ai)
#pragma unroll
            for (int m = 0; m < 4; ++m) {
                const int r = u.pm * 256 + ai * 128 + wr * 64 + m * 16 + fr;
                const int k32 = r & 31, kc = k32 >> 2, pc = (kc < 4) ? 2 * kc : 2 * (kc - 4) + 1, pos = (r & ~31) + pc * 4 + (k32 & 3);
#pragma unroll
                for (int bj = 0; bj < 2; ++bj)
#pragma unroll
                    for (int n = 0; n < 2; ++n) {
                        const int cc = half * 256 + bj * 128 + wc * 32 + n * 16 + 4 * fq;
                        const f32x4 v = acc[ai][bj][m][n];
                        *(f32x4*)(ob + (size_t)r * 512 + cc) = v;
                        if (!kv) { u32x2 w; w.x = cvt_pk_bf16(v[0], v[1]); w.y = cvt_pk_bf16(v[2], v[3]); *(u32x2*)(KM + ((size_t)l * 2048 + r) * 512 + cc) = w; }
                        else {
                            const unsigned w0 = cvt_pk_bf16(v[0], v[1]), w1 = cvt_pk_bf16(v[2], v[3]);
                            bf16_t* vt = VT + ((size_t)l * 512 + cc) * 2048 + pos;
                            vt[0] = (bf16_t)(w0 & 0xffffu); vt[2048] = (bf16_t)(w0 >> 16); vt[4096] = (bf16_t)(w1 & 0xffffu); vt[6144] = (bf16_t)(w1 >> 16);
                        }
                    }
            }
    }
};
struct EpiBrS {
    static constexpr bool AFTER_DRAIN = false, CHAIN = false, PERM = true;
    float* slab3; const bf16_t* gate;
    __device__ __forceinline__ void operator()(AccT& acc, const Unit& u, int wr, int wc, int fr, int fq) const {
        const int sg = u.k0 / u.nkt;
        const int row0 = u.pm * 256 + wr * 64 + fr, col0 = u.pn * 256 + wc * 32 + 8 * fq;
        const bf16_t* gb = gate + (size_t)row0 * NIN + col0 + sg * D;
        float* sb = slab3 + ((size_t)sg * TS + (row0 - TP)) * D + col0;
#pragma unroll
        for (int ai = 0; ai < 2; ++ai)
#pragma unroll
            for (int m = 0; m < 4; ++m) {
                u32x4 gs[2];
#pragma unroll
                for (int bj = 0; bj < 2; ++bj) gs[bj] = *(const u32x4*)(gb + (size_t)(ai * 128 + m * 16) * NIN + bj * 128);
#pragma unroll
                for (int bj = 0; bj < 2; ++bj) { float nn[8]; unpack8(gs[bj], nn); float* pp = sb + (size_t)(ai * 128 + m * 16) * D + bj * 128;
                    f32x4 v0 = acc[ai][bj][m][0], v1 = acc[ai][bj][m][1];
                    v0[0] *= nn[0]; v0[1] *= nn[1]; v0[2] *= nn[2]; v0[3] *= nn[3]; v1[0] *= nn[4]; v1[1] *= nn[5]; v1[2] *= nn[6]; v1[3] *= nn[7];
                    *(f32x4*)pp = v0; *(f32x4*)(pp + 4) = v1; }
                asm volatile("" ::: "memory");
            }
    }
};
struct EpiBr {
    static constexpr bool AFTER_DRAIN = false, CHAIN = true, PERM = true;
    bf16_t* mrg; const bf16_t* gate;
    __device__ __forceinline__ void operator()(AccT& acc, const Unit& u, int wr, int wc, int fr, int fq) const {
        const int sg = u.k0 / u.nkt;
        const int row0 = u.pm * 256 + wr * 64 + fr, col0 = u.pn * 256 + wc * 32 + 8 * fq;
        const bf16_t* gb = gate + (size_t)row0 * NIN + col0 + sg * D; bf16_t* mb = mrg + (size_t)row0 * D + col0;
#pragma unroll
        for (int ai = 0; ai < 2; ++ai) {
            u32x4 gn[4][2], gd[4][2];
#pragma unroll
            for (int m = 0; m < 4; ++m)
#pragma unroll
                for (int bj = 0; bj < 2; ++bj) { const size_t ro = (size_t)(ai * 128 + m * 16); const int co = bj * 128;
                    gn[m][bj] = *(const u32x4*)(gb + ro * NIN + co);
                    if (sg < 2) gd[m][bj] = *(const u32x4*)(gb + ro * NIN + co + D); else gd[m][bj] = gn[m][bj]; }
#pragma unroll
            for (int m = 0; m < 4; ++m)
#pragma unroll
                for (int bj = 0; bj < 2; ++bj) { const size_t ro = (size_t)(ai * 128 + m * 16); const int co = bj * 128;
                    float nn[8], dd[8]; unpack8(gn[m][bj], nn); unpack8(gd[m][bj], dd);
#pragma unroll
                    for (int e = 0; e < 8; ++e) { nn[e] = fmaxf(nn[e], 1e-30f); if (sg < 2) nn[e] *= __builtin_amdgcn_rcpf(fmaxf(dd[e], 1e-30f)); }
                    f32x4 v0 = acc[ai][bj][m][0], v1 = acc[ai][bj][m][1];
                    v0[0] *= nn[0]; v0[1] *= nn[1]; v0[2] *= nn[2]; v0[3] *= nn[3]; v1[0] *= nn[4]; v1[1] *= nn[5]; v1[2] *= nn[6]; v1[3] *= nn[7];
                    if (sg < 2) { acc[ai][bj][m][0] = v0; acc[ai][bj][m][1] = v1; }
                    else { u32x4 w; w.x = cvt_pk_bf16(v0[0], v0[1]); w.y = cvt_pk_bf16(v0[2], v0[3]); w.z = cvt_pk_bf16(v1[0], v1[1]); w.w = cvt_pk_bf16(v1[2], v1[3]); *(u32x4*)(mb + ro * D + co) = w; } }
        }
    }
};

__device__ __forceinline__ void transpose_item(const float* W, int N, bf16_t* WT, int ldd, int row_off, int mode, LAS float* scr, int item, int lane) {
    const int nblk = N / 32, kb = item / nblk, nb = item % nblk, k0 = 64 * kb, n0 = 32 * nb;
    const int drow0 = (mode == 0) ? (row_off + n0) : (((n0 >> 7) << 8) + (n0 & 127) + (mode == 2 ? 128 : 0));
    float wv[32];
#pragma unroll
    for (int i = 0; i < 32; ++i) { const int kk = 2 * i + (lane >> 5); wv[i] = W[(size_t)(k0 + kk) * N + n0 + (lane & 31)]; }
#pragma unroll
    for (int i = 0; i < 32; ++i) { const int kk = 2 * i + (lane >> 5); scr[kk * 33 + (lane & 31)] = wv[i]; }
    asm volatile("s_waitcnt lgkmcnt(0)" ::: "memory");
    const int c = lane & 7;
#pragma unroll
    for (int j = 0; j < 4; ++j) { const int n = (lane >> 3) + 8 * j; const LAS float* s = scr + (8 * c) * 33 + n;
        u32x4 o; o.x = cvt_pk_bf16(s[0 * 33], s[1 * 33]); o.y = cvt_pk_bf16(s[2 * 33], s[3 * 33]); o.z = cvt_pk_bf16(s[4 * 33], s[5 * 33]); o.w = cvt_pk_bf16(s[6 * 33], s[7 * 33]);
        *(u32x4*)(WT + (size_t)(drow0 + n) * ldd + k0 + 8 * c) = o; }
    asm volatile("s_waitcnt lgkmcnt(0)" ::: "memory");
}

__device__ __forceinline__ void row_cvt(const float* src, float* dstf, bf16_t* dstb, int lane, float fscale) {
#pragma unroll
    for (int j = 0; j < 4; ++j) { const f32x4 v = *((const f32x4*)src + lane + 64 * j); if (dstf) *((f32x4*)dstf + lane + 64 * j) = v * fscale;
        u32x2 w; w.x = cvt_pk_bf16(v[0], v[1]); w.y = cvt_pk_bf16(v[2], v[3]); *((u32x2*)dstb + lane + 64 * j) = w; }
}
template <int NSLAB>
__device__ __forceinline__ void ln_row(float* xout, bf16_t* brow, const float* g, const float* b, int lane, const float* slab) {
    f32x4 v[4]; float s = 0.f;
    u32x2 xw[4];
#pragma unroll
    for (int j = 0; j < 4; ++j) xw[j] = *((const u32x2*)brow + lane + 64 * j);
    f32x4 sv[NSLAB][4];
#pragma unroll
    for (int k = 0; k < NSLAB; ++k)
#pragma unroll
        for (int j = 0; j < 4; ++j) sv[k][j] = *((const f32x4*)(slab + (size_t)k * TS * D) + lane + 64 * j);
#pragma unroll
    for (int j = 0; j < 4; ++j) v[j] = (f32x4){bf_lo(xw[j].x), bf_hi(xw[j].x), bf_lo(xw[j].y), bf_hi(xw[j].y)} * ALPHA;
#pragma unroll
    for (int k = 0; k < NSLAB; ++k)
#pragma unroll
        for (int j = 0; j < 4; ++j) v[j] += sv[k][j];
#pragma unroll
    for (int j = 0; j < 4; ++j) s += (v[j][0] + v[j][1]) + (v[j][2] + v[j][3]);
    const float mean = wave_sum(s) * (1.f / D); float s2 = 0.f;
#pragma unroll
    for (int j = 0; j < 4; ++j) { v[j] = v[j] - mean; s2 += (v[j][0] * v[j][0] + v[j][1] * v[j][1]) + (v[j][2] * v[j][2] + v[j][3] * v[j][3]); }
    const float rstd = 1.0f / sqrtf(wave_sum(s2) * (1.f / D) + LN_EPS);
#pragma unroll
    for (int j = 0; j < 4; ++j) { const f32x4 gg = *((const f32x4*)g + lane + 64 * j), bb = *((const f32x4*)b + lane + 64 * j);
        const f32x4 y = v[j] * rstd * gg + bb; if (xout) *((f32x4*)xout + lane + 64 * j) = y;
        u32x2 w; w.x = cvt_pk_bf16(y[0], y[1]); w.y = cvt_pk_bf16(y[2], y[3]); *((u32x2*)brow + lane + 64 * j) = w; }
}

__device__ __forceinline__ void attn_prompt_item(LAS unsigned char* lds, const bf16_t* Z, const bf16_t* KM, const bf16_t* VT, bf16_t* YC, int item, int tid) {
    const int b = item >> 5, h = (item >> 3) & 3, qb = item & 7;
    const int lane = tid & 63, w = tid >> 6, fr = lane & 15, fq = lane >> 4;
    LAS unsigned char* Ks = lds; LAS unsigned char* Vs = lds + 69632;
#pragma unroll
    for (int it = 0; it < 8; ++it) { const int idx = it * 512 + tid, row = idx >> 4, ch = idx & 15;
        const u32x4 v = *(const u32x4*)(KM + (size_t)(b * 256 + row) * 512 + h * 128 + ch * 8); *(LAS u32x4*)(Ks + row * 272 + ch * 16) = v; }
#pragma unroll
    for (int it = 0; it < 8; ++it) { const int idx = it * 512 + tid, d = idx >> 5, ch = idx & 31;
        const u32x4 v = *(const u32x4*)(VT + (size_t)(h * 128 + d) * 2048 + b * 256 + ch * 8); *(LAS u32x4*)(Vs + d * 528 + ch * 16) = v; }
    const size_t qrow0 = (size_t)b * 2048 + qb * 256 + w * 32 + fr;
    bf16x8 qf[2][4];
#pragma unroll
    for (int mt = 0; mt < 2; ++mt)
#pragma unroll
        for (int kk = 0; kk < 4; ++kk) qf[mt][kk] = *(const bf16x8*)(Z + (qrow0 + 16 * mt) * NIN + ZC_Q + h * 128 + kk * 32 + fq * 8);
    __syncthreads();
    f32x4 s[2][16];
#pragma unroll
    for (int mt = 0; mt < 2; ++mt)
#pragma unroll
        for (int n = 0; n < 16; ++n) s[mt][n] = (f32x4){0.f, 0.f, 0.f, 0.f};
#pragma unroll
    for (int n = 0; n < 16; ++n)
#pragma unroll
        for (int kk = 0; kk < 4; ++kk) { const bf16x8 kf = *(const LAS bf16x8*)(Ks + (16 * n + fr) * 272 + (32 * kk + 8 * fq) * 2);
            s[0][n] = __builtin_amdgcn_mfma_f32_16x16x32_bf16(kf, qf[0][kk], s[0][n], 0, 0, 0);
            s[1][n] = __builtin_amdgcn_mfma_f32_16x16x32_bf16(kf, qf[1][kk], s[1][n], 0, 0, 0);
            if (kk == 3 && (n & 1)) __builtin_amdgcn_sched_barrier(0); }
    bf16x8 pf[2][8];
#pragma unroll
    for (int mt = 0; mt < 2; ++mt) {
        float mx = -3.0e38f;
#pragma unroll
        for (int n = 0; n < 16; ++n) mx = fmaxf(mx, fmaxf(fmaxf(s[mt][n][0], s[mt][n][1]), fmaxf(s[mt][n][2], s[mt][n][3])));
        mx = fmaxf(mx, __shfl_xor(mx, 16)); mx = fmaxf(mx, __shfl_xor(mx, 32));
        const float c2 = 0.08838834764831845f * 1.4426950408889634f; float sum = 0.f;
#pragma unroll
        for (int n = 0; n < 16; ++n)
#pragma unroll
            for (int j = 0; j < 4; ++j) { const float e = __builtin_amdgcn_exp2f((s[mt][n][j] - mx) * c2); s[mt][n][j] = e; sum += e; }
        sum += __shfl_xor(sum, 16); sum += __shfl_xor(sum, 32);
        const float inv = 1.0f / sum;
#pragma unroll
        for (int k2 = 0; k2 < 8; ++k2) { u32x4 t; t.x = cvt_pk_bf16(s[mt][2 * k2][0] * inv, s[mt][2 * k2][1] * inv); t.y = cvt_pk_bf16(s[mt][2 * k2][2] * inv, s[mt][2 * k2][3] * inv);
            t.z = cvt_pk_bf16(s[mt][2 * k2 + 1][0] * inv, s[mt][2 * k2 + 1][1] * inv); t.w = cvt_pk_bf16(s[mt][2 * k2 + 1][2] * inv, s[mt][2 * k2 + 1][3] * inv); pf[mt][k2] = __builtin_bit_cast(bf16x8, t); }
        __builtin_amdgcn_sched_barrier(0);
    }
    f32x4 o[2][8];
#pragma unroll
    for (int mt = 0; mt < 2; ++mt)
#pragma unroll
        for (int nd = 0; nd < 8; ++nd) o[mt][nd] = (f32x4){0.f, 0.f, 0.f, 0.f};
#pragma unroll
    for (int k2 = 0; k2 < 8; ++k2)
#pragma unroll
        for (int nd = 0; nd < 8; ++nd) { const bf16x8 vf = *(const LAS bf16x8*)(Vs + (16 * nd + fr) * 528 + (32 * k2 + 8 * fq) * 2);
            o[0][nd] = __builtin_amdgcn_mfma_f32_16x16x32_bf16(vf, pf[0][k2], o[0][nd], 0, 0, 0);
            o[1][nd] = __builtin_amdgcn_mfma_f32_16x16x32_bf16(vf, pf[1][k2], o[1][nd], 0, 0, 0);
            if (nd == 7) __builtin_amdgcn_sched_barrier(0); }
#pragma unroll
    for (int mt = 0; mt < 2; ++mt)
#pragma unroll
        for (int nd = 0; nd < 8; ++nd) { u32x2 wv; wv.x = cvt_pk_bf16(o[mt][nd][0], o[mt][nd][1]); wv.y = cvt_pk_bf16(o[mt][nd][2], o[mt][nd][3]);
            *(u32x2*)(YC + (qrow0 + 16 * mt) * (3 * CW) + h * 128 + 16 * nd + 4 * fq) = wv; }
    __syncthreads();
}

__device__ __forceinline__ void attn_sample_item(LAS unsigned char* lds, const bf16_t* Z, const float* CK, const float* CV, bf16_t* YC, int item, int tid) {
    const int b = item >> 2, h = item & 3;
    const int lane = tid & 63, w = tid >> 6;
    LAS float* S = (LAS float*)lds;
    LAS float* P = (LAS float*)(lds + 4096);
    LAS float* R = (LAS float*)(lds + 8192);
    {
        const int g = lane >> 4, i = lane & 15;
        u32x4 qraw[4];
#pragma unroll
        for (int qi = 0; qi < 4; ++qi) qraw[qi] = *(const u32x4*)(Z + (size_t)(TP + b * 4 + qi) * NIN + ZC_Q + h * 128 + 8 * i);
        const float* kbase = CK + ((size_t)(b * 256) * 4 + h) * 128 + 8 * i;
        f32x4 k0[8], k1[8];
#pragma unroll
        for (int it = 0; it < 8; ++it) { const int key = 32 * w + 4 * it + g; const float* pk = kbase + (size_t)key * 512; k0[it] = *(const f32x4*)pk; k1[it] = *(const f32x4*)(pk + 4); }
        float qv[4][8];
#pragma unroll
        for (int qi = 0; qi < 4; ++qi) unpack8(qraw[qi], qv[qi]);
#pragma unroll
        for (int it = 0; it < 8; ++it) { const int key = 32 * w + 4 * it + g;
#pragma unroll
            for (int qi = 0; qi < 4; ++qi) {
                float sv = k0[it][0] * qv[qi][0] + k0[it][1] * qv[qi][1] + k0[it][2] * qv[qi][2] + k0[it][3] * qv[qi][3]
                         + k1[it][0] * qv[qi][4] + k1[it][1] * qv[qi][5] + k1[it][2] * qv[qi][6] + k1[it][3] * qv[qi][7];
                sv += __shfl_xor(sv, 1); sv += __shfl_xor(sv, 2); sv += __shfl_xor(sv, 4); sv += __shfl_xor(sv, 8);
                if (i == 0) S[qi * 256 + key] = sv * 0.08838834764831845f;
            }
        }
    }
    __syncthreads();
    if (w < 4) {
        float v[4]; float mx = -3.0e38f;
#pragma unroll
        for (int j = 0; j < 4; ++j) { v[j] = S[w * 256 + lane + 64 * j]; mx = fmaxf(mx, v[j]); }
        mx = wave_max(mx); float sum = 0.f;
#pragma unroll
        for (int j = 0; j < 4; ++j) { v[j] = __expf(v[j] - mx); sum += v[j]; }
        sum = wave_sum(sum); const float inv = 1.0f / sum;
#pragma unroll
        for (int j = 0; j < 4; ++j) P[(lane + 64 * j) * 4 + w] = v[j] * inv;
    }
    {
        const int dq = tid & 31, kg = tid >> 5;
        const float* vbase = CV + ((size_t)(b * 256 + 16 * kg) * 4 + h) * 128 + 4 * dq;
        f32x4 vv[16];
#pragma unroll
        for (int key = 0; key < 16; ++key) vv[key] = *(const f32x4*)(vbase + (size_t)key * 512);
        __syncthreads();
        f32x4 a0 = (f32x4){0.f, 0.f, 0.f, 0.f}, a1 = a0, a2 = a0, a3 = a0;
#pragma unroll
        for (int key = 0; key < 16; ++key) { const f32x4 pp = *(const LAS f32x4*)(P + (16 * kg + key) * 4);
            a0 += vv[key] * pp[0]; a1 += vv[key] * pp[1]; a2 += vv[key] * pp[2]; a3 += vv[key] * pp[3]; }
        *(LAS f32x4*)(R + (kg * 4 + 0) * 128 + 4 * dq) = a0; *(LAS f32x4*)(R + (kg * 4 + 1) * 128 + 4 * dq) = a1;
        *(LAS f32x4*)(R + (kg * 4 + 2) * 128 + 4 * dq) = a2; *(LAS f32x4*)(R + (kg * 4 + 3) * 128 + 4 * dq) = a3;
    }
    __syncthreads();
    { const int qi = tid >> 7, d = tid & 127; float o = 0.f;
#pragma unroll
      for (int kg = 0; kg < 16; ++kg) o += R[(kg * 4 + qi) * 128 + d];
      YC[(size_t)(TP + b * 4 + qi) * (3 * CW) + h * 128 + d] = (bf16_t)(cvt_pk_bf16(o, 0.f) & 0xffffu); }
    __syncthreads();
}

struct ZRows { u32x4 a0, b0, a1, b1, a2, b2, a3, b3; };
__device__ __forceinline__ ZRows lru_zload(const bf16_t* Z, int item, int tid) {
    const int rt = item >> 3, n = item & 7, i = tid >> 2, c = n * 64 + (tid & 3) * 16;
    const size_t row = (size_t)rt * 128 + i;
    const int t = (rt < 128) ? (rt & 15) * 128 + i : (i & 3);
    const bf16_t* z0 = Z + row * NIN + ZC_LX + c;
    const bf16_t* z1 = (t >= 1) ? z0 - NIN : z0; const bf16_t* z2 = (t >= 2) ? z0 - 2 * NIN : z0; const bf16_t* z3 = (t >= 3) ? z0 - 3 * NIN : z0;
    ZRows r;
    r.a0 = *(const u32x4*)z0; r.b0 = *(const u32x4*)(z0 + 8); r.a1 = *(const u32x4*)z1; r.b1 = *(const u32x4*)(z1 + 8);
    r.a2 = *(const u32x4*)z2; r.b2 = *(const u32x4*)(z2 + 8); r.a3 = *(const u32x4*)z3; r.b3 = *(const u32x4*)(z3 + 8);
    return r;
}
__device__ __forceinline__ void lru_item(LAS unsigned char* lds, CP p, int l, const bf16_t* Z, const bf16_t* LWA, const bf16_t* LWX,
                                         float* ACUM, float* BCUM, float* AGG, bf16_t* YB, int item, int tid, const ZRows zin, bool fill_prm) {
    const int rt = item >> 3, n = item & 7;
    const bool samp = rt >= 128;
    LAS float* XC = (LAS float*)lds;
    LAS float* BB = (LAS float*)(lds + 34816);
    LAS unsigned char* XCB = lds + 69632;
    LAS unsigned char* WA = lds + 88064;
    LAS unsigned char* WX = lds + 97280;
    LAS float* SEGA = (LAS float*)(lds + 106496);
    LAS float* SEGB = (LAS float*)(lds + 108544);
    LAS float* PRM = (LAS float*)(lds + 110592);
    if (fill_prm) {
        const int r = tid >> 6, ch = tid & 63, cglob = l * 512 + n * 64 + ch;
        float v;
        if (r == 0) v = p->in[26][cglob]; else if (r == 1) v = p->in[28][cglob]; else if (r == 2) v = softplus_neg_(p->in[29][cglob]);
        else if (r == 3) v = p->in[24][cglob]; else v = p->in[23][(size_t)(l * 4 + 3 - (r - 4)) * 512 + n * 64 + ch];
        PRM[r * 64 + ch] = v;
        __syncthreads();
    }
    {
        const int i = tid >> 2, cgp = tid & 3, c = n * 64 + cgp * 16;
        const size_t row = (size_t)rt * 128 + i;
        int t, bb;
        if (!samp) { bb = rt >> 4; t = (rt & 15) * 128 + i; } else { bb = (rt - 128) * 32 + (i >> 2); t = i & 3; }
        float xv[16];
#pragma unroll
        for (int e4 = 0; e4 < 4; ++e4) { const f32x4 bq = *(const LAS f32x4*)(PRM + 3 * 64 + cgp * 16 + 4 * e4); xv[4 * e4] = bq[0]; xv[4 * e4 + 1] = bq[1]; xv[4 * e4 + 2] = bq[2]; xv[4 * e4 + 3] = bq[3]; }
#pragma unroll
        for (int k = 0; k < 4; ++k) {
            float lxv[16];
            { const u32x4 za = (k == 0) ? zin.a0 : (k == 1) ? zin.a1 : (k == 2) ? zin.a2 : zin.a3, zb = (k == 0) ? zin.b0 : (k == 1) ? zin.b1 : (k == 2) ? zin.b2 : zin.b3;
              float f0[8], f1[8]; unpack8(za, f0); unpack8(zb, f1);
#pragma unroll
              for (int e = 0; e < 8; ++e) { lxv[e] = f0[e]; lxv[8 + e] = f1[e]; } }
            if (t - k < 0) {
#pragma unroll
                for (int e = 0; e < 16; ++e) lxv[e] = 0.f;
                if (samp) { const float* sp = p->in[5] + ((size_t)(l * 128 + bb) * 3 + (3 + t - k)) * 512 + c;
#pragma unroll
                    for (int e4 = 0; e4 < 4; ++e4) { const f32x4 v = *(const f32x4*)(sp + 4 * e4); lxv[4 * e4] = v[0]; lxv[4 * e4 + 1] = v[1]; lxv[4 * e4 + 2] = v[2]; lxv[4 * e4 + 3] = v[3]; } }
            }
#pragma unroll
            for (int e4 = 0; e4 < 4; ++e4) { const f32x4 wq = *(const LAS f32x4*)(PRM + (4 + k) * 64 + cgp * 16 + 4 * e4);
                xv[4 * e4] += wq[0] * lxv[4 * e4]; xv[4 * e4 + 1] += wq[1] * lxv[4 * e4 + 1]; xv[4 * e4 + 2] += wq[2] * lxv[4 * e4 + 2]; xv[4 * e4 + 3] += wq[3] * lxv[4 * e4 + 3]; }
            if (k == 0) {
                float* so = nullptr;
                if (!samp) { if (t >= 2045) so = p->out + O_PLCONV + ((size_t)(l * 8 + bb) * 3 + (t - 2045)) * 512 + c; }
                else { if (t >= 1) so = p->out + O_SLCONV + ((size_t)(l * 128 + bb) * 3 + (t - 1)) * 512 + c; }
                if (so) {
#pragma unroll
                    for (int e = 0; e < 16; e += 4) *(f32x4*)(so + e) = (f32x4){lxv[e], lxv[e + 1], lxv[e + 2], lxv[e + 3]};
                }
            }
        }
#pragma unroll
        for (int e = 0; e < 16; e += 4) *(LAS f32x4*)(XC + i * 68 + cgp * 16 + e) = (f32x4){xv[e], xv[e + 1], xv[e + 2], xv[e + 3]};
        u32x4 w0, w1;
        w0.x = cvt_pk_bf16(xv[0], xv[1]); w0.y = cvt_pk_bf16(xv[2], xv[3]); w0.z = cvt_pk_bf16(xv[4], xv[5]); w0.w = cvt_pk_bf16(xv[6], xv[7]);
        w1.x = cvt_pk_bf16(xv[8], xv[9]); w1.y = cvt_pk_bf16(xv[10], xv[11]); w1.z = cvt_pk_bf16(xv[12], xv[13]); w1.w = cvt_pk_bf16(xv[14], xv[15]);
        *(LAS u32x4*)(XCB + i * 144 + cgp * 32) = w0; *(LAS u32x4*)(XCB + i * 144 + cgp * 32 + 16) = w1;
        const int j = tid >> 3, ch = tid & 7;
        *(LAS u32x4*)(WA + j * 144 + ch * 16) = *(const u32x4*)(LWA + (size_t)j * 512 + n * 64 + ch * 8);
        *(LAS u32x4*)(WX + j * 144 + ch * 16) = *(const u32x4*)(LWX + (size_t)j * 512 + n * 64 + ch * 8);
    }
    __syncthreads();
    {
        const int lane = tid & 63, w = tid >> 6, fr = lane & 15, fq = lane >> 4;
        bf16x8 af[2];
#pragma unroll
        for (int ks = 0; ks < 2; ++ks) af[ks] = *(const LAS bf16x8*)(XCB + (16 * w + fr) * 144 + (32 * ks + 8 * fq) * 2);
        f32x4 ra[4], ri[4];
#pragma unroll
        for (int nt = 0; nt < 4; ++nt) { ra[nt] = (f32x4){0.f, 0.f, 0.f, 0.f}; ri[nt] = (f32x4){0.f, 0.f, 0.f, 0.f}; }
#pragma unroll
        for (int nt = 0; nt < 4; ++nt)
#pragma unroll
            for (int ks = 0; ks < 2; ++ks) {
                const bf16x8 wa = *(const LAS bf16x8*)(WA + (16 * nt + fr) * 144 + (32 * ks + 8 * fq) * 2);
                const bf16x8 wx = *(const LAS bf16x8*)(WX + (16 * nt + fr) * 144 + (32 * ks + 8 * fq) * 2);
                ra[nt] = __builtin_amdgcn_mfma_f32_16x16x32_bf16(wa, af[ks], ra[nt], 0, 0, 0);
                ri[nt] = __builtin_amdgcn_mfma_f32_16x16x32_bf16(wx, af[ks], ri[nt], 0, 0, 0);
            }
#pragma unroll
        for (int nt = 0; nt < 4; ++nt) {
            const int chn = 16 * nt + 4 * fq;
            LAS f32x4* xp = (LAS f32x4*)(XC + (16 * w + fr) * 68 + chn);
            const f32x4 xc4 = *xp;
            const f32x4 ba4 = *(const LAS f32x4*)(PRM + chn), bx4 = *(const LAS f32x4*)(PRM + 64 + chn), sp4 = *(const LAS f32x4*)(PRM + 128 + chn);
            f32x4 a4, b4;
#pragma unroll
            for (int j = 0; j < 4; ++j) {
                const float r = sigmoidf_(ra[nt][j] + ba4[j]), ig = sigmoidf_(ri[nt][j] + bx4[j]);
                const float la = -8.0f * r * sp4[j];
                a4[j] = __expf(la);
                b4[j] = __builtin_amdgcn_sqrtf(one_minus_exp_(2.0f * la)) * ig * xc4[j];
            }
            *xp = a4; *(LAS f32x4*)(BB + (16 * w + fr) * 68 + chn) = b4;
        }
    }
    __syncthreads();
    const int c = tid & 63, sg = tid >> 6;
    if (!samp) {
        float A = 1.f, B = 0.f;
#pragma unroll
        for (int tt = 0; tt < 16; ++tt) { const float a = XC[(16 * sg + tt) * 68 + c], b = BB[(16 * sg + tt) * 68 + c]; B = a * B + b; A *= a; }
        SEGA[sg * 64 + c] = A; SEGB[sg * 64 + c] = B;
    }
    __syncthreads();
    {
        float A = 1.f, B = 0.f;
        if (!samp) for (int s2 = 0; s2 < sg; ++s2) { const float sa = SEGA[s2 * 64 + c], sb = SEGB[s2 * 64 + c]; B = sa * B + sb; A *= sa; }
        const size_t base = ((size_t)rt * 128 + 16 * sg) * CW + n * 64 + c;
        if (!samp) {
#pragma unroll
            for (int tt = 0; tt < 16; ++tt) {
                const float a = XC[(16 * sg + tt) * 68 + c], b = BB[(16 * sg + tt) * 68 + c]; B = a * B + b; A *= a;
                const unsigned ab = cvt_pk_bf16(A, B);
                ((bf16_t*)ACUM)[base + (size_t)tt * CW] = (bf16_t)(ab & 0xffffu); ((bf16_t*)BCUM)[base + (size_t)tt * CW] = (bf16_t)(ab >> 16);
            }
            if (sg == 7) { float* ag = AGG + ((size_t)rt * 512 + n * 64 + c) * 2; ag[0] = A; ag[1] = B; }
        } else {
            float h = 0.f;
#pragma unroll
            for (int tt = 0; tt < 16; ++tt) {
                const int tok = 16 * sg + tt, bs = (rt - 128) * 32 + (tok >> 2);
                if ((tt & 3) == 0) h = p->in[6][(size_t)(l * 128 + bs) * 512 + n * 64 + c];
                const float a = XC[tok * 68 + c], b = BB[tok * 68 + c]; h = a * h + b;
                const size_t row = (size_t)rt * 128 + tok;
                const float lg = bf2f(Z[row * NIN + ZC_LG + n * 64 + c]);
                YB[row * (3 * CW) + n * 64 + c] = (bf16_t)(cvt_pk_bf16(h * lg, 0.f) & 0xffffu);
                if ((tt & 3) == 3) p->out[O_SH + (size_t)(l * 128 + bs) * 512 + n * 64 + c] = h;
            }
        }
    }
    __syncthreads();
}

__device__ __forceinline__ void conv_item(CP p, int l, const bf16_t* Z, bf16_t* YA, int ct, int tid) {
    const int rt = ct >> 2;
    const bool samp = rt >= 128;
#pragma unroll 2
    for (int it = 0; it < 4; ++it) {
        const int idx = it * 512 + tid, i = (ct & 3) * 32 + (idx >> 6), c = (idx & 63) * 8;
        const size_t row = (size_t)rt * 128 + i;
        int t, bb;
        if (!samp) { bb = rt >> 4; t = (rt & 15) * 128 + i; } else { bb = (rt - 128) * 32 + (i >> 2); t = i & 3; }
        u32x4 cvr[3], ccr[3]; f32x4 wq[3][2], stq[3][2];
#pragma unroll
        for (int k = 0; k < 3; ++k) { const size_t rk = (t - k >= 0) ? row - k : row; const bf16_t* zp = Z + rk * NIN; cvr[k] = *(const u32x4*)(zp + ZC_CV + c); ccr[k] = *(const u32x4*)(zp + ZC_CC + c); }
        const u32x4 cbr = *(const u32x4*)(Z + row * NIN + ZC_CB + c);
#pragma unroll
        for (int k = 0; k < 3; ++k) { const float* wp = p->in[21] + (size_t)(l * 3 + 2 - k) * 512 + c; wq[k][0] = *(const f32x4*)wp; wq[k][1] = *(const f32x4*)(wp + 4);
            stq[k][0] = (f32x4){0.f, 0.f, 0.f, 0.f}; stq[k][1] = stq[k][0]; }
        if (samp) {
#pragma unroll
            for (int k = 1; k < 3; ++k) { int si = 2 + t - k; si = si < 0 ? 0 : (si > 1 ? 1 : si);
                const float* sp = p->in[4] + ((size_t)(l * 128 + bb) * 2 + si) * 512 + c; stq[k][0] = *(const f32x4*)sp; stq[k][1] = *(const f32x4*)(sp + 4); }
        }
        float uacc[8];
#pragma unroll
        for (int e = 0; e < 8; ++e) uacc[e] = 0.f;
#pragma unroll
        for (int k = 0; k < 3; ++k) {
            float pv[8];
            { float a[8], bq[8]; unpack8(cvr[k], a); unpack8(ccr[k], bq);
#pragma unroll
              for (int e = 0; e < 8; ++e) pv[e] = a[e] * bq[e]; }
            if (t - k < 0) { pv[0] = stq[k][0][0]; pv[1] = stq[k][0][1]; pv[2] = stq[k][0][2]; pv[3] = stq[k][0][3]; pv[4] = stq[k][1][0]; pv[5] = stq[k][1][1]; pv[6] = stq[k][1][2]; pv[7] = stq[k][1][3]; }
            const f32x4 w0 = wq[k][0], w1 = wq[k][1];
            uacc[0] += w0[0] * pv[0]; uacc[1] += w0[1] * pv[1]; uacc[2] += w0[2] * pv[2]; uacc[3] += w0[3] * pv[3];
            uacc[4] += w1[0] * pv[4]; uacc[5] += w1[1] * pv[5]; uacc[6] += w1[2] * pv[6]; uacc[7] += w1[3] * pv[7];
            if (k == 0) {
                float* so = nullptr;
                if (!samp) { if (t >= 2046) so = p->out + O_PCONV + ((size_t)(l * 8 + bb) * 2 + (t - 2046)) * 512 + c; }
                else { if (t >= 2) so = p->out + O_SCONV + ((size_t)(l * 128 + bb) * 2 + (t - 2)) * 512 + c; }
                if (so) { *(f32x4*)so = (f32x4){pv[0], pv[1], pv[2], pv[3]}; *(f32x4*)(so + 4) = (f32x4){pv[4], pv[5], pv[6], pv[7]}; }
            }
        }
        float cbv[8]; unpack8(cbr, cbv);
        u32x4 wv; wv.x = cvt_pk_bf16(cbv[0] * uacc[0], cbv[1] * uacc[1]); wv.y = cvt_pk_bf16(cbv[2] * uacc[2], cbv[3] * uacc[3]);
        wv.z = cvt_pk_bf16(cbv[4] * uacc[4], cbv[5] * uacc[5]); wv.w = cvt_pk_bf16(cbv[6] * uacc[6], cbv[7] * uacc[7]);
        *(u32x4*)(YA + row * (3 * CW) + c) = wv;
    }
}

__device__ __forceinline__ void lru_apply_item(CP p, int l, const bf16_t* Z, const float* ACUM, const float* BCUM, const float* AGG, bf16_t* YB, int rt, int tid) {
    const bool samp = rt >= 128;
    const int c = (tid & 127) * 4, ro = tid >> 7;
    f32x4 carry = (f32x4){0.f, 0.f, 0.f, 0.f};
    const int bb0 = rt >> 4, jc = rt & 15;
    if (!samp) {
        f32x4 q0[15], q1[15];
#pragma unroll
        for (int jj = 0; jj < 15; ++jj) { const float* ag = AGG + ((size_t)(bb0 * 16 + (jj < jc ? jj : 0)) * 512 + c) * 2; q0[jj] = *(const f32x4*)ag; q1[jj] = *(const f32x4*)(ag + 4); }
#pragma unroll
        for (int jj = 0; jj < 15; ++jj) if (jj < jc) {
            carry[0] = q0[jj][0] * carry[0] + q0[jj][1]; carry[1] = q0[jj][2] * carry[1] + q0[jj][3]; carry[2] = q1[jj][0] * carry[2] + q1[jj][1]; carry[3] = q1[jj][2] * carry[3] + q1[jj][3]; }
    }
#pragma unroll 8
    for (int it = 0; it < 32; ++it) {
        const int i = ro + 4 * it; const size_t row = (size_t)rt * 128 + i;
        int bs = 0;
        if (samp) { bs = (rt - 128) * 32 + (i >> 2); carry = *(const f32x4*)(p->in[6] + (size_t)(l * 128 + bs) * 512 + c); }
        const u32x2 aw = *(const u32x2*)((const bf16_t*)ACUM + row * CW + c), bw = *(const u32x2*)((const bf16_t*)BCUM + row * CW + c);
        const f32x4 a4 = (f32x4){bf_lo(aw.x), bf_hi(aw.x), bf_lo(aw.y), bf_hi(aw.y)}, b4 = (f32x4){bf_lo(bw.x), bf_hi(bw.x), bf_lo(bw.y), bf_hi(bw.y)};
        const f32x4 h = a4 * carry + b4;
        const u32x2 gw = *(const u32x2*)(Z + row * NIN + ZC_LG + c);
        u32x2 wv; wv.x = cvt_pk_bf16(h[0] * bf_lo(gw.x), h[1] * bf_hi(gw.x)); wv.y = cvt_pk_bf16(h[2] * bf_lo(gw.y), h[3] * bf_hi(gw.y));
        *(u32x2*)(YB + row * (3 * CW) + c) = wv;
        if (!samp) { if (jc == 15 && i == 127) *(f32x4*)(p->out + O_PH + (size_t)(l * 8 + bb0) * 512 + c) = h; }
        else { if ((i & 3) == 3) *(f32x4*)(p->out + O_SH + (size_t)(l * 128 + bs) * 512 + c) = h; }
    }
}


#define XB_TMO      128
#define XB_XCNT(j)  (256  + 64 * (j))
#define XB_XSUB(j)  (1280 + 64 * (j))
#define XB_XGEN(j)  (2304 + 64 * (j))
#define XB_TOP      3328
#define XB_TOPGEN   3392
#define XCD_BAR_WORDS 3456
#define XB_SPIN_CAP (1u << 20)
__device__ __forceinline__ unsigned xb_ld(unsigned* p)              { return __hip_atomic_load(p, __ATOMIC_RELAXED, __HIP_MEMORY_SCOPE_AGENT); }
__device__ __forceinline__ unsigned xb_add(unsigned* p, unsigned v) { return __hip_atomic_fetch_add(p, v, __ATOMIC_RELAXED, __HIP_MEMORY_SCOPE_AGENT); }
__device__ __forceinline__ unsigned xb_xcc_id() { return (unsigned)__builtin_amdgcn_s_getreg((3 << 11) | 20) & 0xFu; }
#define XB_SPIN(cond, bar) do { unsigned _sp = 0; while (cond) { __builtin_amdgcn_s_sleep(1); \
    if ((++_sp & 255u) == 0u) { if (xb_ld(&(bar)[XB_TMO])) break; if (_sp > XB_SPIN_CAP) { atomicAdd(&(bar)[XB_TMO], 1u); break; } } } } while (0)
struct XcdBarrier { unsigned* bar; unsigned x; volatile LAS unsigned* st; };
__device__ __forceinline__ XcdBarrier xcd_barrier_post(unsigned* bar, volatile LAS unsigned* st) {
    XcdBarrier b; b.bar = bar; b.x = xb_xcc_id(); b.st = st;
    if (threadIdx.x == 0) (void)xb_add(&bar[XB_XCNT(b.x)], 1u);
    return b;
}
__device__ __forceinline__ void xcd_barrier_complete(unsigned* bar, unsigned x, unsigned& nloc, unsigned& nx) {
    const unsigned G = gridDim.x * gridDim.y * gridDim.z;
    unsigned sum, cnt, mine, sp = 0u;
    for (;;) {
        sum = 0u; cnt = 0u; mine = 0u;
#pragma unroll
        for (unsigned j = 0; j < 16; ++j) { const unsigned c = xb_ld(&bar[XB_XCNT(j)]); sum += c; cnt += (c > 0u) ? 1u : 0u; mine = (j == x) ? c : mine; }
        if (sum == G) break;
        __builtin_amdgcn_s_sleep(1);
        if ((++sp & 255u) == 0u) { if (xb_ld(&bar[XB_TMO])) break; if (sp > XB_SPIN_CAP) { atomicAdd(&bar[XB_TMO], 1u); break; } }
    }
    nloc = mine > 0u ? mine : 1u; nx = cnt > 0u ? cnt : 1u;
}
__device__ __forceinline__ void xcd_barrier(const XcdBarrier& b) {
    asm volatile("s_waitcnt vmcnt(0)" ::: "memory");
    __syncthreads();
    if (threadIdx.x == 0) {
        unsigned* bar = b.bar;
        __builtin_amdgcn_s_waitcnt(0);
        unsigned nloc = b.st[0], nx = b.st[1];
        if (nloc == 0u) { xcd_barrier_complete(bar, b.x, nloc, nx); b.st[0] = nloc; b.st[1] = nx; }
        const unsigned old = xb_add(&bar[XB_XSUB(b.x)], 1u);
        const unsigned gen = old / nloc;
        if (old + 1u == (gen + 1u) * nloc) {
            __builtin_amdgcn_fence(__ATOMIC_RELEASE, "agent");
            asm volatile("s_waitcnt vmcnt(0)" ::: "memory");
            const unsigned og = xb_add(&bar[XB_TOP], 1u);
            const unsigned tg = og / nx;
            if (og + 1u == (tg + 1u) * nx) xb_add(&bar[XB_TOPGEN], 1u);
            else XB_SPIN(xb_ld(&bar[XB_TOPGEN]) == tg, bar);
            __builtin_amdgcn_fence(__ATOMIC_ACQUIRE, "agent");
            xb_add(&bar[XB_XGEN(b.x)], 1u);
            asm volatile("s_waitcnt vmcnt(0)" ::: "memory");
        } else {
            XB_SPIN(xb_ld(&bar[XB_XGEN(b.x)]) == gen, bar);
            __builtin_amdgcn_fence(__ATOMIC_ACQUIRE, "agent");
            asm volatile("s_waitcnt vmcnt(0)" ::: "memory");
        }
    }
    __syncthreads();
}

#define WSP(q, off) ((q)->ws + (off))
__global__ void __launch_bounds__(512, 2) mega(Params p_unused) {
    extern __shared__ __attribute__((aligned(16))) unsigned char lds_raw[];
    LAS unsigned char* lds = (LAS unsigned char*)lds_raw;
    cg::grid_group grid = cg::this_grid();
    const int G = gridDim.x, blk = blockIdx.x;
    constexpr int LDS_ST = LDS_BYTES - 64;
    if (threadIdx.x < 16) ((volatile LAS unsigned*)(lds + LDS_ST))[threadIdx.x] = 0u;
    XcdBarrier xb;
    { CP p = kp(); xb = xcd_barrier_post((unsigned*)p->ws, (volatile LAS unsigned*)(lds + LDS_ST));
      if (p->ws == nullptr) grid.sync(); }
#define GRID_SYNC() xcd_barrier(xb)

    {
        CP p = kp(); const int tid = tid_(), lane = tid & 63, wave = __builtin_amdgcn_readfirstlane(tid >> 6);
        unsigned char* ws = p->ws;
        LAS float* scr = (LAS float*)(lds + wave * 16384);
        const int gw = blk * 8 + wave, NGW = G * 8;
        constexpr int I_F = 1408, I_IN = 3072, I_BR = 256, I_O = 512, I_LR = 16, I_KV = 256;
        constexpr int PER_L = 6 * I_F + I_IN + 3 * I_BR + I_O + 2 * I_LR + 2 * I_KV;
        bf16_t* WKV = (bf16_t*)(ws + WS_WKV);
        for (int it = gw; it < 2 * PER_L; it += NGW) {
            const int l = it / PER_L; int r = it - l * PER_L;
            unsigned char* wl = ws + WS_W + (size_t)l * WL_SIZE;
            const size_t fo = (size_t)l * D * FF;
            if (r < I_F) { transpose_item(p->in[14] + fo, FF, (bf16_t*)(wl + WL_GU1), D, 0, 1, scr, r, lane); continue; } r -= I_F;
            if (r < I_F) { transpose_item(p->in[15] + fo, FF, (bf16_t*)(wl + WL_GU1), D, 0, 2, scr, r, lane); continue; } r -= I_F;
            if (r < I_F) { transpose_item(p->in[16] + fo, D, (bf16_t*)(wl + WL_D1), FF, 0, 0, scr, r, lane); continue; } r -= I_F;
            if (r < I_F) { transpose_item(p->in[17] + fo, FF, (bf16_t*)(wl + WL_GU2), D, 0, 1, scr, r, lane); continue; } r -= I_F;
            if (r < I_F) { transpose_item(p->in[18] + fo, FF, (bf16_t*)(wl + WL_GU2), D, 0, 2, scr, r, lane); continue; } r -= I_F;
            if (r < I_F) { transpose_item(p->in[19] + fo, D, (bf16_t*)(wl + WL_D2), FF, 0, 0, scr, r, lane); continue; } r -= I_F;
            if (r < I_IN) { transpose_item(p->in[20] + (size_t)l * D * NIN, NIN, (bf16_t*)(wl + WL_IN), D, 0, 0, scr, r, lane); continue; } r -= I_IN;
            if (r < I_BR) { transpose_item(p->in[22] + (size_t)l * CW * D, D, (bf16_t*)(wl + WL_BR), 3 * CW, 0, 0, scr, r, lane); continue; } r -= I_BR;
            if (r < I_BR) { transpose_item(p->in[30] + (size_t)l * CW * D, D, (bf16_t*)(wl + WL_BR) + CW, 3 * CW, 0, 0, scr, r, lane); continue; } r -= I_BR;
            if (r < I_BR) { transpose_item(p->in[33] + (size_t)l * CW * D, D, (bf16_t*)(wl + WL_BR) + 2 * CW, 3 * CW, 0, 0, scr, r, lane); continue; } r -= I_BR;
            if (r < I_O) { transpose_item(p->in[34] + (size_t)l * D * D, D, (bf16_t*)(wl + WL_O), D, 0, 0, scr, r, lane); continue; } r -= I_O;
            if (r < I_LR) { transpose_item(p->in[25] + (size_t)l * 512 * 64, 64, (bf16_t*)(wl + WL_LWA), 512, 0, 0, scr, r, lane); continue; } r -= I_LR;
            if (r < I_LR) { transpose_item(p->in[27] + (size_t)l * 512 * 64, 64, (bf16_t*)(wl + WL_LWX), 512, 0, 0, scr, r, lane); continue; } r -= I_LR;
            if (r < I_KV) { transpose_item(p->in[31] + (size_t)l * D * CW, CW, WKV, D, l * 1024, 0, scr, r, lane); continue; } r -= I_KV;
            transpose_item(p->in[32] + (size_t)l * D * CW, CW, WKV, D, l * 1024 + 512, 0, scr, r, lane);
        }
        float* X = p->out + O_Y; bf16_t* XB = (bf16_t*)(ws + WS_XB); bf16_t* MEMB = (bf16_t*)(ws + WS_MEMB);
        for (int m = gw; m < T + 2048; m += NGW) {
            if (m < TP) row_cvt(p->in[0] + (size_t)m * D, nullptr, XB + (size_t)m * D, lane, 1.0f);
            else if (m < T) row_cvt(p->in[1] + (size_t)(m - TP) * D, nullptr, XB + (size_t)m * D, lane, 1.0f);
            else row_cvt(p->in[7] + (size_t)(m - T) * D, nullptr, MEMB + (size_t)(m - T) * D, lane, 1.0f);
        }
    }
    GRID_SYNC();

    {
        CP p = kp();
        pg8::Gemm g{(const bf16_t*)WSP(p, WS_MEMB), (const bf16_t*)WSP(p, WS_WKV), 2048, 2048, D}; pg8::StaticOrder S; S.init(2048, 2048, D, G, (blk + 84) % G);
        EpiKV E{p->out, (bf16_t*)WSP(p, WS_KMEM), (bf16_t*)WSP(p, WS_VT)};
        pg8::gemm_phase<EpiKV, pg8::StaticOrder>(lds, g, S, E);
    }

#pragma unroll 1
    for (int s = 0; s < 4; ++s) {
        const int l = s >> 1, half = s & 1;
        {
            CP p = kp(); unsigned char* wl = WSP(p, WS_W + (size_t)l * WL_SIZE);
            pg8::Gemm g{(const bf16_t*)WSP(p, WS_XB), (const bf16_t*)(wl + (half ? WL_GU2 : WL_GU1)), T, 2 * FF, D}; pg8::StaticOrder S; S.init(T, 2 * FF, D, G, blk);
            EpiGU E{(bf16_t*)WSP(p, WS_HZ)};
            pg8::gemm_phase<EpiGU, pg8::StaticOrder>(lds, g, S, E);
        }
        GRID_SYNC();
        {
            CP p = kp(); unsigned char* wl = WSP(p, WS_W + (size_t)l * WL_SIZE);
            pg8::Gemm g{(const bf16_t*)WSP(p, WS_HZ), (const bf16_t*)(wl + (half ? WL_D2 : WL_D1)), T, D, FF}; pg8::TailOrder S; S.init(D, FF, G, blk, 11);
            EpiRes<true> E; E.Xout = (s == 3) ? p->out + O_Y : nullptr; E.slab = (float*)WSP(p, WS_ACUM);
            E.lng = (half ? p->in[12] : p->in[8]) + l * D; E.lnb = (half ? p->in[13] : p->in[9]) + l * D; E.cnt = (unsigned*)p->ws + CW_CNT + s * 4096; E.nmini = 88;
            pg8::gemm_phase<EpiRes<true>, pg8::TailOrder>(lds, g, S, E);
        }
        if (blk >= G - 64) {
            CP p = kp(); const int tid = tid_(), lane = tid & 63, wave = __builtin_amdgcn_readfirstlane(tid >> 6);
            unsigned* sc = (unsigned*)p->ws + CW_CNT + s * 4096 + 32;
            if (wave == 0) { unsigned sp = 0; while ((unsigned)__builtin_amdgcn_readfirstlane(__hip_atomic_load(sc, __ATOMIC_RELAXED, __HIP_MEMORY_SCOPE_AGENT)) < (unsigned)G) { __builtin_amdgcn_s_sleep(2); if (++sp > (1u << 22)) break; }
                __builtin_amdgcn_fence(__ATOMIC_ACQUIRE, "agent"); asm volatile("s_waitcnt vmcnt(0)" ::: "memory"); }
            __syncthreads();
            const float* gp = (half ? p->in[12] : p->in[8]) + l * D; const float* bp = (half ? p->in[13] : p->in[9]) + l * D;
            const int m = TP + (blk - (G - 64)) * 8 + wave;
            ln_row<11>(s == 3 ? p->out + O_Y + (size_t)m * D : nullptr, (bf16_t*)WSP(p, WS_XB) + (size_t)m * D, gp, bp, lane, (const float*)WSP(p, WS_ACUM) + (size_t)(m - TP) * D);
        }
        if (s == 3) break;
        GRID_SYNC();
        if (half) continue;

        {
            CP p = kp(); unsigned char* wl = WSP(p, WS_W + (size_t)l * WL_SIZE);
            pg8::Gemm g{(const bf16_t*)WSP(p, WS_XB), (const bf16_t*)(wl + WL_IN), T, NIN, D}; pg8::StaticOrder S; S.init(T, NIN, D, G, blk);
            EpiZ E{(bf16_t*)WSP(p, WS_HZ)};
            pg8::gemm_phase<EpiZ, pg8::StaticOrder>(lds, g, S, E);
        }
        GRID_SYNC();
#pragma unroll 1
        for (int slot = 0; slot < 4; ++slot) {
            const int cat = (slot + ((blk & 1) << 1)) & 3;
            if (cat == 0) {
                for (int it = blk; it < 256; it += G) { CP p = kp();
                    attn_prompt_item(lds, (const bf16_t*)WSP(p, WS_HZ), (const bf16_t*)WSP(p, WS_KMEM) + (size_t)l * 2048 * 512, (const bf16_t*)WSP(p, WS_VT) + (size_t)l * 512 * 2048,
                                     (bf16_t*)WSP(p, WS_YBR) + 2 * CW, it, tid_()); }
            } else if (cat == 1) {
                for (int it = blk; it < 512; it += G) { CP p = kp();
                    attn_sample_item(lds, (const bf16_t*)WSP(p, WS_HZ), p->in[2] + (size_t)l * 128 * 256 * 512, p->in[3] + (size_t)l * 128 * 256 * 512,
                                     (bf16_t*)WSP(p, WS_YBR) + 2 * CW, it, tid_()); }
            } else if (cat == 2) {
                ZRows zcur;
                { CP p = kp(); zcur = lru_zload((const bf16_t*)WSP(p, WS_HZ), blk < 1056 ? blk : 0, tid_()); }
                for (int it = blk; it < 1056; it += G) { CP p = kp(); unsigned char* wl = WSP(p, WS_W + (size_t)l * WL_SIZE);
                    const ZRows znext = lru_zload((const bf16_t*)WSP(p, WS_HZ), it + G < 1056 ? it + G : it, tid_());
                    lru_item(lds, p, l, (const bf16_t*)WSP(p, WS_HZ), (const bf16_t*)(wl + WL_LWA), (const bf16_t*)(wl + WL_LWX),
                             (float*)WSP(p, WS_ACUM), (float*)WSP(p, WS_BCUM), (float*)WSP(p, WS_AGG), (bf16_t*)WSP(p, WS_YBR) + CW, it, tid_(), zcur, it == blk || (G & 7) != 0);
                    zcur = znext; }
            } else {
                for (int it = (G > 64 ? blk - 32 : blk); it >= 0 && it < 528; it += (G > 64 ? G - 32 : G)) { CP p = kp();
                    conv_item(p, l, (const bf16_t*)WSP(p, WS_HZ), (bf16_t*)WSP(p, WS_YBR), it, tid_()); }
            }
        }
        GRID_SYNC();
#pragma unroll 1
        for (int ph = 0; ph < 2; ++ph) {
            if (ph == 0) {
                for (int it = blk; it < 128; it += G) { CP p = kp();
                    lru_apply_item(p, l, (const bf16_t*)WSP(p, WS_HZ), (const float*)WSP(p, WS_ACUM), (const float*)WSP(p, WS_BCUM), (const float*)WSP(p, WS_AGG),
                                   (bf16_t*)WSP(p, WS_YBR) + CW, it, tid_()); }
            }
            if (ph == 1 && blk >= G - 64) {
                CP p = kp(); const int tid = tid_(), lane = tid & 63, wave = __builtin_amdgcn_readfirstlane(tid >> 6);
                const int m = (blk - (G - 64)) * 8 + wave;
                const float* sb = (const float*)WSP(p, WS_SLB3) + (size_t)m * D; bf16_t* mo = (bf16_t*)WSP(p, WS_MRG) + (size_t)(TP + m) * D;
#pragma unroll
                for (int j = 0; j < 4; ++j) { const f32x4 v = *((const f32x4*)sb + lane + 64 * j) + *((const f32x4*)(sb + (size_t)TS * D) + lane + 64 * j) + *((const f32x4*)(sb + 2 * (size_t)TS * D) + lane + 64 * j);
                    u32x2 w; w.x = cvt_pk_bf16(v[0], v[1]); w.y = cvt_pk_bf16(v[2], v[3]); *((u32x2*)mo + lane + 64 * j) = w; }
            }
            if (ph == 0 && blk >= G - 24) {
                CP p = kp(); unsigned char* wl = WSP(p, WS_W + (size_t)l * WL_SIZE);
                pg8::Gemm g{(const bf16_t*)WSP(p, WS_YBR), (const bf16_t*)(wl + WL_BR), T, D, 3 * CW}; pg8::ChainOrder S; S.init(TP, D, 3 * CW, G, blk, __builtin_amdgcn_readfirstlane(blk - (G - 24)));
                EpiBrS E{(float*)WSP(p, WS_SLB3), (const bf16_t*)WSP(p, WS_HZ) + ZC_GL};
                pg8::gemm_phase<EpiBrS, pg8::ChainOrder>(lds, g, S, E);
            }
            if (ph == 1) {
                CP p = kp(); unsigned char* wl = WSP(p, WS_W + (size_t)l * WL_SIZE);
                pg8::Gemm g{(const bf16_t*)WSP(p, WS_YBR), (const bf16_t*)(wl + WL_BR), T, D, 3 * CW}; pg8::ChainOrder S; S.init(TP, D, 3 * CW, G, blk, -1);
                EpiBr E{(bf16_t*)WSP(p, WS_MRG), (const bf16_t*)WSP(p, WS_HZ) + ZC_GL};
                pg8::gemm_phase<EpiBr, pg8::ChainOrder>(lds, g, S, E);
            }
            GRID_SYNC();
        }
        {
            CP p = kp(); unsigned char* wl = WSP(p, WS_W + (size_t)l * WL_SIZE);
            pg8::Gemm g{(const bf16_t*)WSP(p, WS_MRG), (const bf16_t*)(wl + WL_O), T, D, D}; pg8::TailOrder S; S.init(D, D, G, blk, 8);
            EpiRes<false> E; E.Xout = nullptr; E.slab = (float*)WSP(p, WS_ACUM);
            E.lng = p->in[10] + l * D; E.lnb = p->in[11] + l * D; E.cnt = (unsigned*)p->ws + CW_CNT + (4 + l) * 4096; E.nmini = 64;
            pg8::gemm_phase<EpiRes<false>, pg8::TailOrder>(lds, g, S, E);
        }
        if (blk >= G - 64) {
            CP p = kp(); const int tid = tid_(), lane = tid & 63, wave = __builtin_amdgcn_readfirstlane(tid >> 6);
            unsigned* sc = (unsigned*)p->ws + CW_CNT + (4 + l) * 4096 + 32;
            if (wave == 0) { unsigned sp = 0; while ((unsigned)__builtin_amdgcn_readfirstlane(__hip_atomic_load(sc, __ATOMIC_RELAXED, __HIP_MEMORY_SCOPE_AGENT)) < (unsigned)G) { __builtin_amdgcn_s_sleep(2); if (++sp > (1u << 22)) break; }
                __builtin_amdgcn_fence(__ATOMIC_ACQUIRE, "agent"); asm volatile("s_waitcnt vmcnt(0)" ::: "memory"); }
            __syncthreads();
            const int m = TP + (blk - (G - 64)) * 8 + wave;
            ln_row<8>(nullptr, (bf16_t*)WSP(p, WS_XB) + (size_t)m * D, p->in[10] + l * D, p->in[11] + l * D, lane, (const float*)WSP(p, WS_ACUM) + (size_t)(m - TP) * D);
        }
        GRID_SYNC();
    }
}

extern "C" void kernel_launch(void* const* d_in, const int* in_sizes, int n_in, void* d_out, int out_size, void* d_ws, size_t ws_size, hipStream_t stream) {
    static int grid_blocks = 0;
    if (!grid_blocks) {
        int dev = 0, cus = 0, per_cu = 0;
        (void)hipGetDevice(&dev);
        (void)hipDeviceGetAttribute(&cus, hipDeviceAttributeMultiprocessorCount, dev);
        (void)hipFuncSetAttribute((const void*)mega, hipFuncAttributeMaxDynamicSharedMemorySize, LDS_BYTES);
        (void)hipOccupancyMaxActiveBlocksPerMultiprocessor(&per_cu, (const void*)mega, 512, LDS_BYTES);
        if (per_cu < 1) per_cu = 1;
        grid_blocks = cus * per_cu;
        if (ws_size < WS_END) fprintf(stderr, "kernel_launch: workspace too small: %zu < %zu\n", ws_size, (size_t)WS_END);
    }
    Params p{};
    for (int i = 0; i < 35; ++i) p.in[i] = (const float*)d_in[i];
    p.out = (float*)d_out; p.ws = (unsigned char*)d_ws;
    void* args[] = {&p};
    (void)hipMemsetAsync(d_ws, 0, (size_t)CW_WORDS * 4, stream);
    hipError_t e = hipLaunchCooperativeKernel((const void*)mega, dim3(grid_blocks), dim3(512), args, LDS_BYTES, stream);
    if (e != hipSuccess) fprintf(stderr, "cooperative launch failed: %s (grid %d)\n", hipGetErrorString(e), grid_blocks);
}
```

```cpp
#include <hip/hip_runtime.h>
#include <hip/hip_cooperative_groups.h>
#include <cstdio>
namespace cg = cooperative_groups;

#define LAS __attribute__((address_space(3)))
typedef unsigned short bf16_t;
typedef short bf16x8 __attribute__((ext_vector_type(8)));
typedef float f32x4 __attribute__((ext_vector_type(4)));
typedef unsigned u32x4 __attribute__((ext_vector_type(4)));
typedef unsigned u32x2 __attribute__((ext_vector_type(2)));

constexpr int TP = 16384, TS = 512, T = TP + TS, D = 1024, FF = 2816, NIN = 6144, CW = 512;
constexpr int ZC_CV = 0, ZC_CB = 512, ZC_CC = 1024, ZC_LX = 1536, ZC_LG = 2048, ZC_Q = 2560, ZC_GL = 3072;
constexpr float ALPHA = 1.41421356237309515f, LN_EPS = 1e-5f;
constexpr int LDS_BYTES = 147456;
constexpr size_t O_Y = 0, O_PK = 17301504, O_PV = 19398656, O_PCONV = 21495808, O_PLCONV = 21512192, O_PH = 21536768,
                 O_SCONV = 21544960, O_SLCONV = 21807104, O_SH = 22200320;
constexpr size_t SZ_WGU = (size_t)2 * FF * D * 2, SZ_WD = (size_t)D * FF * 2, SZ_WIN = (size_t)NIN * D * 2, SZ_WBR = (size_t)D * CW * 2,
                 SZ_WO = (size_t)D * D * 2, SZ_LRUW = (size_t)64 * 512 * 2;
constexpr size_t WL_GU1 = 0, WL_D1 = WL_GU1 + SZ_WGU, WL_GU2 = WL_D1 + SZ_WD, WL_D2 = WL_GU2 + SZ_WGU, WL_IN = WL_D2 + SZ_WD,
                 WL_BR = WL_IN + SZ_WIN, WL_O = WL_BR + 3 * SZ_WBR, WL_LWA = WL_O + SZ_WO, WL_LWX = WL_LWA + SZ_LRUW, WL_SIZE = WL_LWX + SZ_LRUW;
constexpr size_t MiB = 1u << 20;
constexpr size_t WS_W = 1 * MiB, WS_WKV = WS_W + 2 * WL_SIZE, WS_MEMB = WS_WKV + 4 * MiB, WS_KMEM = WS_MEMB + 4 * MiB, WS_VT = WS_KMEM + 4 * MiB,
                 WS_XB = WS_VT + 4 * MiB, WS_HZ = WS_XB + (size_t)T * D * 2, WS_YBR = WS_HZ + (size_t)T * NIN * 2,
                 WS_ACUM = WS_YBR + 3 * (size_t)T * CW * 2, WS_BCUM = WS_ACUM + (size_t)T * CW * 4, WS_AGG = WS_BCUM + (size_t)T * CW * 4,
                 WS_MRG = WS_AGG + (size_t)132 * 512 * 2 * 4, WS_END = WS_MRG + (size_t)T * D * 2;
static_assert(WS_END < 565ull * 1000 * 1000, "workspace budget");
constexpr size_t WS_SLB3 = WS_ACUM + (size_t)T * CW * 2;
static_assert(WS_SLB3 + 3 * (size_t)TS * D * 4 <= WS_BCUM, "sample branch slabs fit behind the bf16 cumulants");

constexpr int CW_CNT = 4096, CW_WORDS = 4096 + 6 * 64 * 64;
constexpr size_t WS_XCH = 512 * 1024;
struct Params { const float* in[35]; float* out; unsigned char* ws; };
typedef const __attribute__((address_space(4))) Params* CP;
__device__ __forceinline__ CP kp() { CP q = (CP)__builtin_amdgcn_kernarg_segment_ptr(); asm volatile("" : "+s"(q)); return q; }
__device__ __forceinline__ int tid_() { int t = threadIdx.x; asm volatile("" : "+v"(t)); return t; }

__device__ __forceinline__ unsigned cvt_pk_bf16(float lo, float hi) { unsigned r; asm("v_cvt_pk_bf16_f32 %0, %1, %2" : "=v"(r) : "v"(lo), "v"(hi)); return r; }
__device__ __forceinline__ float bf_lo(unsigned u) { return __uint_as_float(u << 16); }
__device__ __forceinline__ float bf_hi(unsigned u) { return __uint_as_float(u & 0xffff0000u); }
__device__ __forceinline__ float bf2f(bf16_t b) { return __uint_as_float(((unsigned)b) << 16); }
__device__ __forceinline__ float sigmoidf_(float x) { return __builtin_amdgcn_rcpf(1.0f + __expf(-x)); }
__device__ __forceinline__ float silu_(float x) { return x * sigmoidf_(x); }
__device__ __forceinline__ float one_minus_exp_(float x) {
    const float ser = -x * (1.0f + x * (0.5f + x * (0.16666667f + x * (0.041666668f + x * (0.0083333338f + x * 0.0013888889f)))));
    return x > -0.25f ? ser : 1.0f - __expf(x);
}
__device__ __forceinline__ float softplus_neg_(float lam) {
    const float y = __expf(-lam);
    const float ser = y * (1.0f - y * (0.5f - y * (0.33333334f - y * 0.25f)));
    return y < 0.03f ? ser : __logf(1.0f + y);
}
__device__ __forceinline__ float gelu_tanh_(float x) { return x * sigmoidf_(1.5957691216057308f * (x + 0.044715f * x * x * x)); }
__device__ __forceinline__ float wave_sum(float v) {
#pragma unroll
    for (int o = 1; o < 64; o <<= 1) v += __shfl_xor(v, o);
    return v;
}
__device__ __forceinline__ float wave_max(float v) {
#pragma unroll
    for (int o = 1; o < 64; o <<= 1) v = fmaxf(v, __shfl_xor(v, o));
    return v;
}
__device__ __forceinline__ void unpack8(const u32x4 v, float (&f)[8]) {
    f[0] = bf_lo(v.x); f[1] = bf_hi(v.x); f[2] = bf_lo(v.y); f[3] = bf_hi(v.y); f[4] = bf_lo(v.z); f[5] = bf_hi(v.z); f[6] = bf_lo(v.w); f[7] = bf_hi(v.w);
}

namespace pg8 {
constexpr int BM = 256, BK = 64, HALF = 128, HTB = HALF * BK * 2, STAGE_BYTES = 8 * HTB, NXCD = 8, WGM = 8;
__device__ __forceinline__ int lds_byte(int r, int c) { const int st = (r >> 4) * 2 + (c >> 5), rr = r & 15, cc = c & 31, ob = rr * 64 + cc * 2; return st * 1024 + (ob ^ (((ob >> 9) & 1) << 5)); }
__device__ __forceinline__ void stage_rc(int b, int& R, int& C) { const int st = b / 1024, sb = b % 1024, swz = sb ^ (((sb >> 9) & 1) << 5); R = (st >> 1) * 16 + swz / 64; C = (st & 1) * 32 + (swz % 64) / 2; }
__device__ __forceinline__ int perm32(int rho) { const int n = rho >> 4, i = rho & 15; return 8 * (i >> 2) + 4 * n + (i & 3); }
struct Unit { int pm, pn, k0, nkt; };
struct Gemm { const bf16_t* A; const bf16_t* Bt; int M, N, K; };
struct StaticOrder {
    int nM, nN, nwg, G, c, kt;
    __device__ __forceinline__ void init(int M, int N, int K, int G_, int c_) { nM = M / BM; nN = N / BM; nwg = nM * nN; G = G_; c = c_; kt = K / BK; }
    __device__ __forceinline__ bool next(int i, int& pm, int& pn, int& k0, int& nkt) const {
        const int L = i * G + c; k0 = 0; nkt = kt; pm = 0; pn = 0;
        if (L >= nwg) return false;
        int wgid = L; { const int q = nwg / NXCD, r = nwg % NXCD, xcd = wgid % NXCD, off = wgid / NXCD; wgid = (xcd < r ? xcd * (q + 1) : r * (q + 1) + (xcd - r) * q) + off; }
        const int nig = WGM * nN, gid = wgid / nig, fm = gid * WGM, gsz = (nM - fm) < WGM ? (nM - fm) : WGM;
        pm = fm + ((wgid % nig) % gsz); pn = (wgid % nig) / gsz; return true;
    }
};

struct TailOrder {
    StaticOrder P; int nsplit, ktm, nmini;
    __device__ __forceinline__ void init(int N, int K, int G_, int c_, int nsplit_) { P.init(16384, N, K, G_, c_); nsplit = nsplit_; ktm = (K / BK) / nsplit_; nmini = 2 * P.nN * nsplit_; }
    __device__ __forceinline__ bool next(int i, int& pm, int& pn, int& k0, int& nkt) const {
        const bool has_mini = P.c < nmini;
        if (has_mini && i == 0) { const int j = P.c, tile = j / nsplit, sp = j - tile * nsplit;
            pm = 64 + tile / P.nN; pn = tile % P.nN; k0 = sp * ktm; nkt = ktm; return true; }
        const int ip = has_mini ? i - 1 : i;
        const bool ok = P.next(0, pm, pn, k0, nkt);
        return ok && ip == 0;
    }
};

struct ChainOrder {
    StaticOrder P; int segk, sc;
    __device__ __forceinline__ void init(int M, int N, int K, int G_, int c_, int sc_) { P.init(M, N, K, G_, c_); segk = (K / BK) / 3; sc = sc_; }
    __device__ __forceinline__ bool next(int i, int& pm, int& pn, int& k0, int& nkt) const {
        const int r = i / 3, sg = i - 3 * r; int d0, d1;
        bool ok = P.next(r, pm, pn, d0, d1);
        k0 = sg * segk; nkt = segk;
        if (sc >= 0) { const int tile = sc / 3; pm = 64 + (tile >> 2); pn = tile & 3; k0 = (sc - 3 * tile) * segk; ok = (i == 0); }
        return ok;
    }
};

template <class Epi, class Sched>
__device__ __forceinline__ void gemm_phase(LAS unsigned char* lds, const Gemm g, const Sched& S, const Epi& E) {
    const int tid = tid_(), wid = __builtin_amdgcn_readfirstlane(tid >> 6), lane = tid & 63, wr = wid >> 2, wc = wid & 3, fr = lane & 15, fq = lane >> 4;
    const int K = g.K;
    unsigned voffA[2], voffB[2];
#pragma unroll
    for (int i = 0; i < 2; ++i) { int R, C; stage_rc(tid * 16 + i * 8192, R, C); const int Rb = Epi::PERM ? ((R & ~31) + perm32(R & 31)) : R;
        voffA[i] = (unsigned)(R * K + C) * 2u; voffB[i] = (unsigned)(Rb * K + C) * 2u; }
    const size_t kstep = (size_t)(BK * 2);
    const size_t hstep = (size_t)HALF * K * 2;
    const size_t tstep = 2 * hstep;
    const unsigned ldsw = (unsigned)wid * 1024u;
    const int aoff = lds_byte(wr * 64 + fr, fq * 8), boff = lds_byte(wc * 32 + fr, fq * 8);
#define PG8_SA(b, h) (((b) * 2 + (h)) * HTB)
#define PG8_SB(b, h) ((4 + (b) * 2 + (h)) * HTB)
#define PG8_STAGE(bufoff, gbase, voff) do { _Pragma("unroll") for (int _i = 0; _i < 2; ++_i) \
        __builtin_amdgcn_global_load_lds((const unsigned*)((const char*)(gbase) + (voff)[_i]), (LAS unsigned*)(lds + (bufoff) + ldsw + _i * 8192), 16, 0, 0); } while (0)
#define PG8_LDA(dst, b, h) do { _Pragma("unroll") for (int m = 0; m < 4; ++m) _Pragma("unroll") for (int k = 0; k < 2; ++k) dst[m][k] = *(const LAS bf16x8*)(lds + PG8_SA(b, h) + aoff + m * 2048 + k * 1024); } while (0)
#define PG8_LDB(dst, b, h) do { _Pragma("unroll") for (int n = 0; n < 2; ++n) _Pragma("unroll") for (int k = 0; k < 2; ++k) dst[n][k] = *(const LAS bf16x8*)(lds + PG8_SB(b, h) + boff + n * 2048 + k * 1024); } while (0)
#define PG8_MMA(ai, bj, At, Bt) do { __builtin_amdgcn_s_setprio(1); _Pragma("unroll") for (int m = 0; m < 4; ++m) _Pragma("unroll") for (int n = 0; n < 2; ++n) _Pragma("unroll") for (int k = 0; k < 2; ++k) \
        acc[ai][bj][m][n] = __builtin_amdgcn_mfma_f32_16x16x32_bf16(Bt[n][k], At[m][k], acc[ai][bj][m][n], 0, 0, 0); __builtin_amdgcn_s_setprio(0); } while (0)
#define PG8_WAIT_V(n) asm volatile("s_waitcnt vmcnt(" #n ")" ::: "memory")
#define PG8_WAIT_L(n) asm volatile("s_waitcnt lgkmcnt(" #n ")" ::: "memory")
#define PG8_BAR __builtin_amdgcn_s_barrier()
#define PG8_SCHED __builtin_amdgcn_sched_barrier(0)
    int cpm, cpn, ck0, cnk, npm, npn, nk0, nnk; int ui = 0;
    if (!S.next(0, cpm, cpn, ck0, cnk)) return;
    f32x4 acc[2][2][4][2];
#pragma unroll
    for (int a = 0; a < 2; ++a)
#pragma unroll
        for (int b = 0; b < 2; ++b)
#pragma unroll
            for (int m = 0; m < 4; ++m)
#pragma unroll
                for (int n = 0; n < 2; ++n) acc[a][b][m][n] = (f32x4){0.f, 0.f, 0.f, 0.f};
    bf16x8 At[4][2], B0[2][2], B1[2][2];
    const char* cA = (const char*)g.A + (size_t)cpm * tstep + (size_t)ck0 * kstep; const char* cB = (const char*)g.Bt + (size_t)cpn * tstep + (size_t)ck0 * kstep;
    PG8_STAGE(PG8_SB(0, 0), cB, voffB); PG8_STAGE(PG8_SA(0, 0), cA, voffA); PG8_STAGE(PG8_SB(0, 1), cB + hstep, voffB); PG8_STAGE(PG8_SA(0, 1), cA + hstep, voffA);
    if (wr == 1) PG8_BAR;
    PG8_WAIT_V(4); PG8_BAR;
    PG8_STAGE(PG8_SB(1, 0), cB + kstep, voffB); PG8_STAGE(PG8_SA(1, 0), cA + kstep, voffA); PG8_STAGE(PG8_SB(1, 1), cB + hstep + kstep, voffB);
    PG8_WAIT_V(6); PG8_BAR;
    for (;;) {
        const bool has_next = S.next(ui + 1, npm, npn, nk0, nnk);
        const char* nA = has_next ? (const char*)g.A + (size_t)npm * tstep + (size_t)nk0 * kstep : cA; const char* nB = has_next ? (const char*)g.Bt + (size_t)npn * tstep + (size_t)nk0 * kstep : cB;
        const int nt = cnk;
        for (int t = 0; t < nt; t += 2) {
            const bool last = (t == nt - 2);
            const char* a1 = cA + (size_t)(t + 1) * kstep;
            const char* a2 = last ? nA : cA + (size_t)(t + 2) * kstep; const char* b2 = last ? nB : cB + (size_t)(t + 2) * kstep;
            const char* a3 = a2 + kstep; const char* b3 = b2 + kstep;
            PG8_LDB(B0, 0, 0); PG8_SCHED; PG8_LDA(At, 0, 0); PG8_STAGE(PG8_SA(1, 1), a1 + hstep, voffA);
            PG8_WAIT_L(8); PG8_BAR; PG8_WAIT_L(0); PG8_MMA(0, 0, At, B0); PG8_BAR; PG8_SCHED;
            PG8_LDB(B1, 0, 1); PG8_STAGE(PG8_SB(0, 0), b2, voffB);
            PG8_BAR; PG8_WAIT_L(0); PG8_MMA(0, 1, At, B1); PG8_BAR;
            PG8_LDA(At, 0, 1); PG8_STAGE(PG8_SA(0, 0), a2, voffA);
            PG8_BAR; PG8_WAIT_L(0); PG8_MMA(1, 0, At, B0); PG8_BAR; PG8_SCHED;
            PG8_STAGE(PG8_SB(0, 1), b2 + hstep, voffB);
            PG8_WAIT_V(6); PG8_BAR; PG8_MMA(1, 1, At, B1); PG8_BAR;
            PG8_LDB(B0, 1, 0); PG8_SCHED; PG8_LDA(At, 1, 0); PG8_STAGE(PG8_SA(0, 1), a2 + hstep, voffA);
            PG8_WAIT_L(8); PG8_BAR; PG8_WAIT_L(0); PG8_MMA(0, 0, At, B0); PG8_BAR; PG8_SCHED;
            PG8_LDB(B1, 1, 1); PG8_STAGE(PG8_SB(1, 0), b3, voffB);
            PG8_BAR; PG8_WAIT_L(0); PG8_MMA(0, 1, At, B1); PG8_BAR;
            PG8_LDA(At, 1, 1); PG8_STAGE(PG8_SA(1, 0), a3, voffA);
            PG8_BAR; PG8_WAIT_L(0); PG8_MMA(1, 0, At, B0); PG8_BAR; PG8_SCHED;
            PG8_STAGE(PG8_SB(1, 1), b3 + hstep, voffB);
            PG8_WAIT_V(6); PG8_BAR; PG8_MMA(1, 1, At, B1); PG8_BAR;
        }
        if (has_next || !Epi::AFTER_DRAIN) { Unit cu; cu.pm = cpm; cu.pn = cpn; cu.k0 = ck0; cu.nkt = cnk; E(acc, cu, wr, wc, fr, fq); }
        if (!has_next) break;
        if (!(Epi::CHAIN && nk0 != 0)) {
#pragma unroll
        for (int a = 0; a < 2; ++a)
#pragma unroll
            for (int b = 0; b < 2; ++b)
#pragma unroll
                for (int m = 0; m < 4; ++m)
#pragma unroll
                    for (int n = 0; n < 2; ++n) acc[a][b][m][n] = (f32x4){0.f, 0.f, 0.f, 0.f};
        }
        cpm = npm; cpn = npn; ck0 = nk0; cnk = nnk; cA = nA; cB = nB; ++ui;
    }
    PG8_WAIT_V(0);
    if (wr == 0) PG8_BAR;
    PG8_BAR;
    if constexpr (Epi::AFTER_DRAIN) E.fused(acc, cpm, cpn, wr, wc, fr, fq, lds, wid, lane);
#undef PG8_SA
#undef PG8_SB
#undef PG8_STAGE
#undef PG8_LDA
#undef PG8_LDB
#undef PG8_MMA
#undef PG8_WAIT_V
#undef PG8_WAIT_L
#undef PG8_BAR
#undef PG8_SCHED
}
}
using pg8::Unit;
typedef f32x4 AccT[2][2][4][2];

struct EpiGU {
    static constexpr bool AFTER_DRAIN = false, CHAIN = false, PERM = true;
    bf16_t* H;
    __device__ __forceinline__ void operator()(AccT& acc, const Unit& u, int wr, int wc, int fr, int fq) const {
        const int row0 = u.pm * 256 + wr * 64 + fr, col0 = u.pn * 128 + wc * 32 + 8 * fq;
#pragma unroll
        for (int ai = 0; ai < 2; ++ai)
#pragma unroll
            for (int m = 0; m < 4; ++m) {
                bf16_t* rowp = H + (size_t)(row0 + ai * 128 + m * 16) * FF + col0;
                const f32x4 g0 = acc[ai][0][m][0], g1 = acc[ai][0][m][1], u0 = acc[ai][1][m][0], u1 = acc[ai][1][m][1];
                u32x4 w;
                w.x = cvt_pk_bf16(silu_(g0[0]) * u0[0], silu_(g0[1]) * u0[1]); w.y = cvt_pk_bf16(silu_(g0[2]) * u0[2], silu_(g0[3]) * u0[3]);
                w.z = cvt_pk_bf16(silu_(g1[0]) * u1[0], silu_(g1[1]) * u1[1]); w.w = cvt_pk_bf16(silu_(g1[2]) * u1[2], silu_(g1[3]) * u1[3]);
                *(u32x4*)rowp = w;
            }
    }
};
__device__ __forceinline__ void panel_stats_run(unsigned* xbuf, unsigned* cnt, const AccT& v, const int upm, const int upn, int wr, int wc, int fr, int fq, LAS unsigned char* lds, int wid, int lane) {
    {
        typedef float f32x2v __attribute__((ext_vector_type(2)));
        LAS f32x2v* Pt = (LAS f32x2v*)lds;
        LAS f32x2v* St = (LAS f32x2v*)(lds + 8192);
#pragma unroll
        for (int ai = 0; ai < 2; ++ai)
#pragma unroll
            for (int m = 0; m < 4; ++m) {
                float s = 0.f;
#pragma unroll
                for (int bj = 0; bj < 2; ++bj)
#pragma unroll
                    for (int n = 0; n < 2; ++n) { const f32x4 x = v[ai][bj][m][n]; s += (x[0] + x[1]) + (x[2] + x[3]); }
                s += __shfl_xor(s, 16); s += __shfl_xor(s, 32);
                const float mw = s * (1.0f / 64.0f); float q = 0.f;
#pragma unroll
                for (int bj = 0; bj < 2; ++bj)
#pragma unroll
                    for (int n = 0; n < 2; ++n) { const f32x4 d = v[ai][bj][m][n] - mw; q += (d[0] * d[0] + d[1] * d[1]) + (d[2] * d[2] + d[3] * d[3]); }
                q += __shfl_xor(q, 16); q += __shfl_xor(q, 32);
                if (fq == 0) Pt[(ai * 128 + wr * 64 + m * 16 + fr) * 4 + wc] = (f32x2v){mw, q};
                __builtin_amdgcn_sched_barrier(0);
            }
        asm volatile("s_waitcnt lgkmcnt(0)" ::: "memory"); __builtin_amdgcn_s_barrier(); asm volatile("" ::: "memory");
        const int row = wid * 32 + (lane & 31);
        if (lane < 32) {
            const f32x2v a = Pt[row * 4 + 0], b = Pt[row * 4 + 1], c = Pt[row * 4 + 2], d = Pt[row * 4 + 3];
            const float mt = (a.x + b.x + c.x + d.x) * 0.25f;
            const float da = a.x - mt, db = b.x - mt, dc = c.x - mt, dd = d.x - mt;
            const float m2 = (a.y + b.y) + (c.y + d.y) + 64.0f * ((da * da + db * db) + (dc * dc + dd * dd));
            unsigned long long* slot = (unsigned long long*)xbuf + ((size_t)(upm * 256 + row) * 4 + upn);
            __hip_atomic_store(slot, ((unsigned long long)__float_as_uint(m2) << 32) | __float_as_uint(mt), __ATOMIC_RELAXED, __HIP_MEMORY_SCOPE_AGENT);
        }
        asm volatile("s_waitcnt vmcnt(0)" ::: "memory");
        if (lane == 0) __hip_atomic_fetch_add(cnt + 64 * upm, 1u, __ATOMIC_RELAXED, __HIP_MEMORY_SCOPE_AGENT);
        if (wid == 0) {
            unsigned sp = 0;
            while ((unsigned)__builtin_amdgcn_readfirstlane(__hip_atomic_load(cnt + 64 * upm, __ATOMIC_RELAXED, __HIP_MEMORY_SCOPE_AGENT)) < 32u) {
                __builtin_amdgcn_s_sleep(2); if (++sp > (1u << 22)) break; }
            __builtin_amdgcn_fence(__ATOMIC_ACQUIRE, "agent");
        }
        asm volatile("s_waitcnt vmcnt(0) lgkmcnt(0)" ::: "memory"); __builtin_amdgcn_s_barrier(); asm volatile("" ::: "memory");
        if (lane < 32) {
            const unsigned long long* slot = (const unsigned long long*)xbuf + (size_t)(upm * 256 + row) * 4; float mt[4], m2[4]; float ms = 0.f;
#pragma unroll
            for (int t = 0; t < 4; ++t) { const unsigned long long w = __hip_atomic_load(slot + t, __ATOMIC_RELAXED, __HIP_MEMORY_SCOPE_AGENT); mt[t] = __uint_as_float((unsigned)w); m2[t] = __uint_as_float((unsigned)(w >> 32)); ms += mt[t]; }
            const float mean = ms * 0.25f; float q = 0.f;
#pragma unroll
            for (int t = 0; t < 4; ++t) { const float dm = mt[t] - mean; q += m2[t] + 256.0f * dm * dm; }
            St[row] = (f32x2v){mean, 1.0f / sqrtf(q * (1.0f / 1024.0f) + LN_EPS)};
        }
        asm volatile("s_waitcnt lgkmcnt(0)" ::: "memory"); __builtin_amdgcn_s_barrier(); asm volatile("" ::: "memory");
    }
}
template <bool HALF> struct EpiRes {
    static constexpr bool CHAIN = false, PERM = true, AFTER_DRAIN = true;
    static constexpr float scale = HALF ? 0.5f : 1.0f;
    float* Xout; float* slab; const float* lng; const float* lnb; unsigned* cnt; int nmini;
    __device__ __forceinline__ void operator()(AccT& acc, const Unit& u, int wr, int wc, int fr, int fq) const {
        const int row0 = u.pm * 256 + wr * 64 + fr, col0 = u.pn * 256 + wc * 32 + 8 * fq;
        const int sp = u.k0 / u.nkt;
        float* base = slab + ((size_t)sp * TS + (row0 - TP)) * D + col0;
#pragma unroll
        for (int ai = 0; ai < 2; ++ai)
#pragma unroll
            for (int m = 0; m < 4; ++m)
#pragma unroll
                for (int bj = 0; bj < 2; ++bj) { float* pp = base + (size_t)(ai * 128 + m * 16) * D + bj * 128;
                    *(f32x4*)pp = acc[ai][bj][m][0] * scale; *(f32x4*)(pp + 4) = acc[ai][bj][m][1] * scale; }
    }
    __device__ __forceinline__ void fused(AccT& acc, const int upm, const int upn, int, int, int, int, LAS unsigned char* lds, int, int) const {
        typedef float f32x2v __attribute__((ext_vector_type(2)));
        const int tid2 = tid_(), wid = __builtin_amdgcn_readfirstlane(tid2 >> 6), lane = tid2 & 63, wr = wid >> 2, wc = wid & 3, fr = lane & 15, fq = lane >> 4;
        const int row0 = upm * 256 + wr * 64 + fr, col0 = upn * 256 + wc * 32 + 8 * fq;
        bf16_t* XB = (bf16_t*)((unsigned char*)slab - (WS_ACUM - WS_XB)); unsigned* xbuf = (unsigned*)((unsigned char*)slab - (WS_ACUM - WS_XCH));
        bf16_t* bb = XB + (size_t)row0 * D + col0;
        if (wid == 0) {
            if ((int)blockIdx.x < nmini) { __builtin_amdgcn_fence(__ATOMIC_RELEASE, "agent"); asm volatile("s_waitcnt vmcnt(0)" ::: "memory"); }
            if (lane == 0) __hip_atomic_fetch_add(cnt + 32, 1u, __ATOMIC_RELAXED, __HIP_MEMORY_SCOPE_AGENT);
        }
        {
            u32x4 v[2][4][2];
#pragma unroll
            for (int ai = 0; ai < 2; ++ai)
#pragma unroll
                for (int m = 0; m < 4; ++m)
#pragma unroll
                    for (int bj = 0; bj < 2; ++bj) v[ai][m][bj] = *(const u32x4*)(bb + (size_t)(ai * 128 + m * 16) * D + bj * 128);
#pragma unroll
            for (int ai = 0; ai < 2; ++ai) {
#pragma unroll
                for (int m = 0; m < 4; ++m)
#pragma unroll
                    for (int bj = 0; bj < 2; ++bj) { float x[8]; unpack8(v[ai][m][bj], x);
                        acc[ai][bj][m][0] = (f32x4){x[0], x[1], x[2], x[3]} * ALPHA + acc[ai][bj][m][0] * scale;
                        acc[ai][bj][m][1] = (f32x4){x[4], x[5], x[6], x[7]} * ALPHA + acc[ai][bj][m][1] * scale; }
#pragma unroll
                for (int m = 0; m < 4; ++m) asm volatile("" : "+v"(acc[ai][0][m][0]), "+v"(acc[ai][0][m][1]), "+v"(acc[ai][1][m][0]), "+v"(acc[ai][1][m][1]));
            }
            asm volatile("" ::: "memory");
        }
        panel_stats_run(xbuf, cnt, acc, upm, upn, wr, wc, fr, fq, lds, wid, lane);
        asm volatile("" ::: "memory");
        const LAS f32x2v* St = (const LAS f32x2v*)(lds + 8192);
        float* xo = Xout ? Xout + (size_t)row0 * D + col0 : nullptr;
        f32x4 gq[2][2], bq[2][2];
#pragma unroll
        for (int bj = 0; bj < 2; ++bj) { gq[bj][0] = *(const f32x4*)(lng + col0 + bj * 128); gq[bj][1] = *(const f32x4*)(lng + col0 + bj * 128 + 4);
            bq[bj][0] = *(const f32x4*)(lnb + col0 + bj * 128); bq[bj][1] = *(const f32x4*)(lnb + col0 + bj * 128 + 4); }
#pragma unroll
        for (int ai = 0; ai < 2; ++ai)
#pragma unroll
            for (int m = 0; m < 4; ++m) { const f32x2v sr = St[ai * 128 + wr * 64 + m * 16 + fr];
#pragma unroll
                for (int bj = 0; bj < 2; ++bj) { const size_t off = (size_t)(ai * 128 + m * 16) * D + bj * 128;
                    const f32x4 g0 = gq[bj][0], g1 = gq[bj][1], b0 = bq[bj][0], b1 = bq[bj][1];
                    const f32x4 y0 = (acc[ai][bj][m][0] - sr.x) * sr.y * g0 + b0, y1 = (acc[ai][bj][m][1] - sr.x) * sr.y * g1 + b1;
                    if (xo) { *(f32x4*)(xo + off) = y0; *(f32x4*)(xo + off + 4) = y1; }
                    u32x4 w; w.x = cvt_pk_bf16(y0[0], y0[1]); w.y = cvt_pk_bf16(y0[2], y0[3]); w.z = cvt_pk_bf16(y1[0], y1[1]); w.w = cvt_pk_bf16(y1[2], y1[3]); *(u32x4*)(bb + off) = w; }
                asm volatile("" ::: "memory"); }
    }
};
struct EpiZ {
    static constexpr bool AFTER_DRAIN = false, CHAIN = false, PERM = true;
    bf16_t* Z;
    __device__ __forceinline__ void operator()(AccT& acc, const Unit& u, int wr, int wc, int fr, int fq) const {
        const int row0 = u.pm * 256 + wr * 64 + fr, col0 = u.pn * 256 + wc * 32 + 8 * fq;
        const int mode = (u.pn >= 12) ? 2 : ((u.pn == 8 || u.pn == 9) ? 1 : 0);
#pragma unroll
        for (int ai = 0; ai < 2; ++ai)
#pragma unroll
            for (int m = 0; m < 4; ++m) {
                bf16_t* rowp = Z + (size_t)(row0 + ai * 128 + m * 16) * NIN + col0;
#pragma unroll
                for (int bj = 0; bj < 2; ++bj) {
                    f32x4 v0 = acc[ai][bj][m][0], v1 = acc[ai][bj][m][1];
                    if (mode == 2) {
#pragma unroll
                        for (int j = 0; j < 4; ++j) { v0[j] = sigmoidf_(v0[j]); v1[j] = sigmoidf_(v1[j]); }
                    } else if (mode == 1) {
#pragma unroll
                        for (int j = 0; j < 4; ++j) { v0[j] = gelu_tanh_(v0[j]); v1[j] = gelu_tanh_(v1[j]); }
                    }
                    u32x4 w; w.x = cvt_pk_bf16(v0[0], v0[1]); w.y = cvt_pk_bf16(v0[2], v0[3]); w.z = cvt_pk_bf16(v1[0], v1[1]); w.w = cvt_pk_bf16(v1[2], v1[3]);
                    *(u32x4*)(rowp + bj * 128) = w;
                }
            }
    }
};
struct EpiKV {
    static constexpr bool AFTER_DRAIN = false, CHAIN = false, PERM = false;
    float* out; bf16_t* KM; bf16_t* VT;
    __device__ __forceinline__ void operator()(AccT& acc, const Unit& u, int wr, int wc, int fr, int fq) const {
        const int l = u.pn >> 2, kv = (u.pn >> 1) & 1, half = u.pn & 1;
        float* ob = out + (kv ? O_PV : O_PK) + (size_t)l * 2048 * 512;
#pragma unroll
        for (int ai = 0; ai < 2; ++ai)
#pragma unroll
            for (int m = 0; m < 4; ++m) {
                const int r = u.pm * 256 + ai * 128 + wr * 64 + m * 16 + fr;
                const int k32 = r & 31, kc = k32 >> 2, pc = (kc < 4) ? 2 * kc : 2 * (kc - 4) + 1, pos = (r & ~31) + pc * 4 + (k32 & 3);
#pragma unroll
                for (int bj = 0; bj < 2; ++bj)
#pragma unroll
                    for (int n = 0; n < 2; ++n) {
                        const int cc = half * 256 + bj * 128 + wc * 32 + n * 16 + 4 * fq;
                        const f32x4 v = acc[ai][bj][m][n];
                        *(f32x4*)(ob + (size_t)r * 512 + cc) = v;
                        if (!kv) { u32x2 w; w.x = cvt_pk_bf16(v[0], v[1]); w.y = cvt_pk_bf16(v[2], v[3]); *(u32x2*)(KM + ((size_t)l * 2048 + r) * 512 + cc) = w; }
                        else {
                            const unsigned w0 = cvt_pk_bf16(v[0], v[1]), w1 = cvt_pk_bf16(v[2], v[3]);
                            bf16_t* vt = VT + ((size_t)l * 512 + cc) * 2048 + pos;
                            vt[0] = (bf16_t)(w0 & 0xffffu); vt[2048] = (bf16_t)(w0 >> 16); vt[4096] = (bf16_t)(w1 & 0xffffu); vt[6144] = (bf16_t)(w1 >> 16);
                        }
                    }
            }
    }
};
struct EpiBrS {
    static constexpr bool AFTER_DRAIN = false, CHAIN = false, PERM = true;
    float* slab3; const bf16_t* gate;
    __device__ __forceinline__ void operator()(AccT& acc, const Unit& u, int wr, int wc, int fr, int fq) const {
        const int sg = u.k0 / u.nkt;
        const int row0 = u.pm * 256 + wr * 64 + fr, col0 = u.pn * 256 + wc * 32 + 8 * fq;
        const bf16_t* gb = gate + (size_t)row0 * NIN + col0 + sg * D;
        float* sb = slab3 + ((size_t)sg * TS + (row0 - TP)) * D + col0;
#pragma unroll
        for (int ai = 0; ai < 2; ++ai)
#pragma unroll
            for (int m = 0; m < 4; ++m) {
                u32x4 gs[2];
#pragma unroll
                for (int bj = 0; bj < 2; ++bj) gs[bj] = *(const u32x4*)(gb + (size_t)(ai * 128 + m * 16) * NIN + bj * 128);
#pragma unroll
                for (int bj = 0; bj < 2; ++bj) { float nn[8]; unpack8(gs[bj], nn); float* pp = sb + (size_t)(ai * 128 + m * 16) * D + bj * 128;
                    f32x4 v0 = acc[ai][bj][m][0], v1 = acc[ai][bj][m][1];
                    v0[0] *= nn[0]; v0[1] *= nn[1]; v0[2] *= nn[2]; v0[3] *= nn[3]; v1[0] *= nn[4]; v1[1] *= nn[5]; v1[2] *= nn[6]; v1[3] *= nn[7];
                    *(f32x4*)pp = v0; *(f32x4*)(pp + 4) = v1; }
                asm volatile("" ::: "memory");
            }
    }
};
struct EpiBr {
    static constexpr bool AFTER_DRAIN = false, CHAIN = true, PERM = true;
    bf16_t* mrg; const bf16_t* gate;
    __device__ __forceinline__ void operator()(AccT& acc, const Unit& u, int wr, int wc, int fr, int fq) const {
        const int sg = u.k0 / u.nkt;
        const int row0 = u.pm * 256 + wr * 64 + fr, col0 = u.pn * 256 + wc * 32 + 8 * fq;
        const bf16_t* gb = gate + (size_t)row0 * NIN + col0 + sg * D; bf16_t* mb = mrg + (size_t)row0 * D + col0;
#pragma unroll
        for (int ai = 0; ai < 2; ++ai) {
            u32x4 gn[4][2], gd[4][2];
#pragma unroll
            for (int m = 0; m < 4; ++m)
#pragma unroll
                for (int bj = 0; bj < 2; ++bj) { const size_t ro = (size_t)(ai * 128 + m * 16); const int co = bj * 128;
                    gn[m][bj] = *(const u32x4*)(gb + ro * NIN + co);
                    if (sg < 2) gd[m][bj] = *(const u32x4*)(gb + ro * NIN + co + D); else gd[m][bj] = gn[m][bj]; }
#pragma unroll
            for (int m = 0; m < 4; ++m)
#pragma unroll
                for (int bj = 0; bj < 2; ++bj) { const size_t ro = (size_t)(ai * 128 + m * 16); const int co = bj * 128;
                    float nn[8], dd[8]; unpack8(gn[m][bj], nn); unpack8(gd[m][bj], dd);
#pragma unroll
                    for (int e = 0; e < 8; ++e) { nn[e] = fmaxf(nn[e], 1e-30f); if (sg < 2) nn[e] *= __builtin_amdgcn_rcpf(fmaxf(dd[e], 1e-30f)); }
                    f32x4 v0 = acc[ai][bj][m][0], v1 = acc[ai][bj][m][1];
                    v0[0] *= nn[0]; v0[1] *= nn[1]; v0[2] *= nn[2]; v0[3] *= nn[3]; v1[0] *= nn[4]; v1[1] *= nn[5]; v1[2] *= nn[6]; v1[3] *= nn[7];
                    if (sg < 2) { acc[ai][bj][m][0] = v0; acc[ai][bj][m][1] = v1; }
                    else { u32x4 w; w.x = cvt_pk_bf16(v0[0], v0[1]); w.y = cvt_pk_bf16(v0[2], v0[3]); w.z = cvt_pk_bf16(v1[0], v1[1]); w.w = cvt_pk_bf16(v1[2], v1[3]); *(u32x4*)(mb + ro * D + co) = w; } }
        }
    }
};

__device__ __forceinline__ void transpose_item(const float* W, int N, bf16_t* WT, int ldd, int row_off, int mode, LAS float* scr, int item, int lane) {
    const int nblk = N / 32, kb = item / nblk, nb = item % nblk, k0 = 64 * kb, n0 = 32 * nb;
    const int drow0 = (mode == 0) ? (row_off + n0) : (((n0 >> 7) << 8) + (n0 & 127) + (mode == 2 ? 128 : 0));
    float wv[32];
#pragma unroll
    for (int i = 0; i < 32; ++i) { const int kk = 2 * i + (lane >> 5); wv[i] = __builtin_nontemporal_load(W + (size_t)(k0 + kk) * N + n0 + (lane & 31)); }
#pragma unroll
    for (int i = 0; i < 32; ++i) { const int kk = 2 * i + (lane >> 5); scr[kk * 33 + (lane & 31)] = wv[i]; }
    asm volatile("s_waitcnt lgkmcnt(0)" ::: "memory");
    const int c = lane & 7;
#pragma unroll
    for (int j = 0; j < 4; ++j) { const int n = (lane >> 3) + 8 * j; const LAS float* s = scr + (8 * c) * 33 + n;
        u32x4 o; o.x = cvt_pk_bf16(s[0 * 33], s[1 * 33]); o.y = cvt_pk_bf16(s[2 * 33], s[3 * 33]); o.z = cvt_pk_bf16(s[4 * 33], s[5 * 33]); o.w = cvt_pk_bf16(s[6 * 33], s[7 * 33]);
        *(u32x4*)(WT + (size_t)(drow0 + n) * ldd + k0 + 8 * c) = o; }
    asm volatile("s_waitcnt lgkmcnt(0)" ::: "memory");
}

__device__ __forceinline__ void row_cvt(const float* src, float* dstf, bf16_t* dstb, int lane, float fscale) {
#pragma unroll
    for (int j = 0; j < 4; ++j) { const f32x4 v = *((const f32x4*)src + lane + 64 * j); if (dstf) *((f32x4*)dstf + lane + 64 * j) = v * fscale;
        u32x2 w; w.x = cvt_pk_bf16(v[0], v[1]); w.y = cvt_pk_bf16(v[2], v[3]); *((u32x2*)dstb + lane + 64 * j) = w; }
}
template <int NSLAB>
__device__ __forceinline__ void ln_row(float* xout, bf16_t* brow, const float* g, const float* b, int lane, const float* slab) {
    f32x4 v[4]; float s = 0.f;
    u32x2 xw[4];
#pragma unroll
    for (int j = 0; j < 4; ++j) xw[j] = *((const u32x2*)brow + lane + 64 * j);
    f32x4 sv[NSLAB][4];
#pragma unroll
    for (int k = 0; k < NSLAB; ++k)
#pragma unroll
        for (int j = 0; j < 4; ++j) sv[k][j] = *((const f32x4*)(slab + (size_t)k * TS * D) + lane + 64 * j);
#pragma unroll
    for (int j = 0; j < 4; ++j) v[j] = (f32x4){bf_lo(xw[j].x), bf_hi(xw[j].x), bf_lo(xw[j].y), bf_hi(xw[j].y)} * ALPHA;
#pragma unroll
    for (int k = 0; k < NSLAB; ++k)
#pragma unroll
        for (int j = 0; j < 4; ++j) v[j] += sv[k][j];
#pragma unroll
    for (int j = 0; j < 4; ++j) s += (v[j][0] + v[j][1]) + (v[j][2] + v[j][3]);
    const float mean = wave_sum(s) * (1.f / D); float s2 = 0.f;
#pragma unroll
    for (int j = 0; j < 4; ++j) { v[j] = v[j] - mean; s2 += (v[j][0] * v[j][0] + v[j][1] * v[j][1]) + (v[j][2] * v[j][2] + v[j][3] * v[j][3]); }
    const float rstd = 1.0f / sqrtf(wave_sum(s2) * (1.f / D) + LN_EPS);
#pragma unroll
    for (int j = 0; j < 4; ++j) { const f32x4 gg = *((const f32x4*)g + lane + 64 * j), bb = *((const f32x4*)b + lane + 64 * j);
        const f32x4 y = v[j] * rstd * gg + bb; if (xout) *((f32x4*)xout + lane + 64 * j) = y;
        u32x2 w; w.x = cvt_pk_bf16(y[0], y[1]); w.y = cvt_pk_bf16(y[2], y[3]); *((u32x2*)brow + lane + 64 * j) = w; }
}

__device__ __forceinline__ void attn_prompt_item(LAS unsigned char* lds, const bf16_t* Z, const bf16_t* KM, const bf16_t* VT, bf16_t* YC, int item, int tid) {
    const int b = item >> 5, h = (item >> 3) & 3, qb = item & 7;
    const int lane = tid & 63, w = tid >> 6, fr = lane & 15, fq = lane >> 4;
    LAS unsigned char* Ks = lds; LAS unsigned char* Vs = lds + 69632;
#pragma unroll
    for (int it = 0; it < 8; ++it) { const int idx = it * 512 + tid, row = idx >> 4, ch = idx & 15;
        const u32x4 v = *(const u32x4*)(KM + (size_t)(b * 256 + row) * 512 + h * 128 + ch * 8); *(LAS u32x4*)(Ks + row * 272 + ch * 16) = v; }
#pragma unroll
    for (int it = 0; it < 8; ++it) { const int idx = it * 512 + tid, d = idx >> 5, ch = idx & 31;
        const u32x4 v = *(const u32x4*)(VT + (size_t)(h * 128 + d) * 2048 + b * 256 + ch * 8); *(LAS u32x4*)(Vs + d * 528 + ch * 16) = v; }
    const size_t qrow0 = (size_t)b * 2048 + qb * 256 + w * 32 + fr;
    bf16x8 qf[2][4];
#pragma unroll
    for (int mt = 0; mt < 2; ++mt)
#pragma unroll
        for (int kk = 0; kk < 4; ++kk) qf[mt][kk] = *(const bf16x8*)(Z + (qrow0 + 16 * mt) * NIN + ZC_Q + h * 128 + kk * 32 + fq * 8);
    __syncthreads();
    f32x4 s[2][16];
#pragma unroll
    for (int mt = 0; mt < 2; ++mt)
#pragma unroll
        for (int n = 0; n < 16; ++n) s[mt][n] = (f32x4){0.f, 0.f, 0.f, 0.f};
#pragma unroll
    for (int n = 0; n < 16; ++n)
#pragma unroll
        for (int kk = 0; kk < 4; ++kk) { const bf16x8 kf = *(const LAS bf16x8*)(Ks + (16 * n + fr) * 272 + (32 * kk + 8 * fq) * 2);
            s[0][n] = __builtin_amdgcn_mfma_f32_16x16x32_bf16(kf, qf[0][kk], s[0][n], 0, 0, 0);
            s[1][n] = __builtin_amdgcn_mfma_f32_16x16x32_bf16(kf, qf[1][kk], s[1][n], 0, 0, 0);
            if (kk == 3 && (n & 1)) __builtin_amdgcn_sched_barrier(0); }
    bf16x8 pf[2][8];
#pragma unroll
    for (int mt = 0; mt < 2; ++mt) {
        float mx = -3.0e38f;
#pragma unroll
        for (int n = 0; n < 16; ++n) mx = fmaxf(mx, fmaxf(fmaxf(s[mt][n][0], s[mt][n][1]), fmaxf(s[mt][n][2], s[mt][n][3])));
        mx = fmaxf(mx, __shfl_xor(mx, 16)); mx = fmaxf(mx, __shfl_xor(mx, 32));
        const float c2 = 0.08838834764831845f * 1.4426950408889634f; float sum = 0.f;
#pragma unroll
        for (int n = 0; n < 16; ++n)
#pragma unroll
            for (int j = 0; j < 4; ++j) { const float e = __builtin_amdgcn_exp2f((s[mt][n][j] - mx) * c2); s[mt][n][j] = e; sum += e; }
        sum += __shfl_xor(sum, 16); sum += __shfl_xor(sum, 32);
        const float inv = 1.0f / sum;
#pragma unroll
        for (int k2 = 0; k2 < 8; ++k2) { u32x4 t; t.x = cvt_pk_bf16(s[mt][2 * k2][0] * inv, s[mt][2 * k2][1] * inv); t.y = cvt_pk_bf16(s[mt][2 * k2][2] * inv, s[mt][2 * k2][3] * inv);
            t.z = cvt_pk_bf16(s[mt][2 * k2 + 1][0] * inv, s[mt][2 * k2 + 1][1] * inv); t.w = cvt_pk_bf16(s[mt][2 * k2 + 1][2] * inv, s[mt][2 * k2 + 1][3] * inv); pf[mt][k2] = __builtin_bit_cast(bf16x8, t); }
        __builtin_amdgcn_sched_barrier(0);
    }
    f32x4 o[2][8];
#pragma unroll
    for (int mt = 0; mt < 2; ++mt)
#pragma unroll
        for (int nd = 0; nd < 8; ++nd) o[mt][nd] = (f32x4){0.f, 0.f, 0.f, 0.f};
#pragma unroll
    for (int k2 = 0; k2 < 8; ++k2)
#pragma unroll
        for (int nd = 0; nd < 8; ++nd) { const bf16x8 vf = *(const LAS bf16x8*)(Vs + (16 * nd + fr) * 528 + (32 * k2 + 8 * fq) * 2);
            o[0][nd] = __builtin_amdgcn_mfma_f32_16x16x32_bf16(vf, pf[0][k2], o[0][nd], 0, 0, 0);
            o[1][nd] = __builtin_amdgcn_mfma_f32_16x16x32_bf16(vf, pf[1][k2], o[1][nd], 0, 0, 0);
            if (nd == 7) __builtin_amdgcn_sched_barrier(0); }
#pragma unroll
    for (int mt = 0; mt < 2; ++mt)
#pragma unroll
        for (int nd = 0; nd < 8; ++nd) { u32x2 wv; wv.x = cvt_pk_bf16(o[mt][nd][0], o[mt][nd][1]); wv.y = cvt_pk_bf16(o[mt][nd][2], o[mt][nd][3]);
            *(u32x2*)(YC + (qrow0 + 16 * mt) * (3 * CW) + h * 128 + 16 * nd + 4 * fq) = wv; }
    __syncthreads();
}

__device__ __forceinline__ void attn_sample_item(LAS unsigned char* lds, const bf16_t* Z, const float* CK, const float* CV, bf16_t* YC, int item, int tid) {
    const int b = item >> 2, h = item & 3;
    const int lane = tid & 63, w = tid >> 6;
    LAS float* S = (LAS float*)lds;
    LAS float* P = (LAS float*)(lds + 4096);
    LAS float* R = (LAS float*)(lds + 8192);
    {
        const int g = lane >> 4, i = lane & 15;
        u32x4 qraw[4];
#pragma unroll
        for (int qi = 0; qi < 4; ++qi) qraw[qi] = *(const u32x4*)(Z + (size_t)(TP + b * 4 + qi) * NIN + ZC_Q + h * 128 + 8 * i);
        const float* kbase = CK + ((size_t)(b * 256) * 4 + h) * 128 + 8 * i;
        f32x4 k0[8], k1[8];
#pragma unroll
        for (int it = 0; it < 8; ++it) { const int key = 32 * w + 4 * it + g; const float* pk = kbase + (size_t)key * 512; k0[it] = *(const f32x4*)pk; k1[it] = *(const f32x4*)(pk + 4); }
        float qv[4][8];
#pragma unroll
        for (int qi = 0; qi < 4; ++qi) unpack8(qraw[qi], qv[qi]);
#pragma unroll
        for (int it = 0; it < 8; ++it) { const int key = 32 * w + 4 * it + g;
#pragma unroll
            for (int qi = 0; qi < 4; ++qi) {
                float sv = k0[it][0] * qv[qi][0] + k0[it][1] * qv[qi][1] + k0[it][2] * qv[qi][2] + k0[it][3] * qv[qi][3]
                         + k1[it][0] * qv[qi][4] + k1[it][1] * qv[qi][5] + k1[it][2] * qv[qi][6] + k1[it][3] * qv[qi][7];
                sv += __shfl_xor(sv, 1); sv += __shfl_xor(sv, 2); sv += __shfl_xor(sv, 4); sv += __shfl_xor(sv, 8);
                if (i == 0) S[qi * 256 + key] = sv * 0.08838834764831845f;
            }
        }
    }
    __syncthreads();
    if (w < 4) {
        float v[4]; float mx = -3.0e38f;
#pragma unroll
        for (int j = 0; j < 4; ++j) { v[j] = S[w * 256 + lane + 64 * j]; mx = fmaxf(mx, v[j]); }
        mx = wave_max(mx); float sum = 0.f;
#pragma unroll
        for (int j = 0; j < 4; ++j) { v[j] = __expf(v[j] - mx); sum += v[j]; }
        sum = wave_sum(sum); const float inv = 1.0f / sum;
#pragma unroll
        for (int j = 0; j < 4; ++j) P[(lane + 64 * j) * 4 + w] = v[j] * inv;
    }
    {
        const int dq = tid & 31, kg = tid >> 5;
        const float* vbase = CV + ((size_t)(b * 256 + 16 * kg) * 4 + h) * 128 + 4 * dq;
        f32x4 vv[16];
#pragma unroll
        for (int key = 0; key < 16; ++key) vv[key] = *(const f32x4*)(vbase + (size_t)key * 512);
        __syncthreads();
        f32x4 a0 = (f32x4){0.f, 0.f, 0.f, 0.f}, a1 = a0, a2 = a0, a3 = a0;
#pragma unroll
        for (int key = 0; key < 16; ++key) { const f32x4 pp = *(const LAS f32x4*)(P + (16 * kg + key) * 4);
            a0 += vv[key] * pp[0]; a1 += vv[key] * pp[1]; a2 += vv[key] * pp[2]; a3 += vv[key] * pp[3]; }
        *(LAS f32x4*)(R + (kg * 4 + 0) * 128 + 4 * dq) = a0; *(LAS f32x4*)(R + (kg * 4 + 1) * 128 + 4 * dq) = a1;
        *(LAS f32x4*)(R + (kg * 4 + 2) * 128 + 4 * dq) = a2; *(LAS f32x4*)(R + (kg * 4 + 3) * 128 + 4 * dq) = a3;
    }
    __syncthreads();
    { const int qi = tid >> 7, d = tid & 127; float o = 0.f;
#pragma unroll
      for (int kg = 0; kg < 16; ++kg) o += R[(kg * 4 + qi) * 128 + d];
      YC[(size_t)(TP + b * 4 + qi) * (3 * CW) + h * 128 + d] = (bf16_t)(cvt_pk_bf16(o, 0.f) & 0xffffu); }
    __syncthreads();
}

struct ZRows { u32x4 a0, b0, a1, b1, a2, b2, a3, b3; };
__device__ __forceinline__ ZRows lru_zload(const bf16_t* Z, int item, int tid) {
    const int rt = item >> 3, n = item & 7, i = tid >> 2, c = n * 64 + (tid & 3) * 16;
    const size_t row = (size_t)rt * 128 + i;
    const int t = (rt < 128) ? (rt & 15) * 128 + i : (i & 3);
    const bf16_t* z0 = Z + row * NIN + ZC_LX + c;
    const bf16_t* z1 = (t >= 1) ? z0 - NIN : z0; const bf16_t* z2 = (t >= 2) ? z0 - 2 * NIN : z0; const bf16_t* z3 = (t >= 3) ? z0 - 3 * NIN : z0;
    ZRows r;
    r.a0 = *(const u32x4*)z0; r.b0 = *(const u32x4*)(z0 + 8); r.a1 = *(const u32x4*)z1; r.b1 = *(const u32x4*)(z1 + 8);
    r.a2 = *(const u32x4*)z2; r.b2 = *(const u32x4*)(z2 + 8); r.a3 = *(const u32x4*)z3; r.b3 = *(const u32x4*)(z3 + 8);
    return r;
}
__device__ __forceinline__ void lru_item(LAS unsigned char* lds, CP p, int l, const bf16_t* Z, const bf16_t* LWA, const bf16_t* LWX,
                                         float* ACUM, float* BCUM, float* AGG, bf16_t* YB, int item, int tid, const ZRows zin, bool fill_prm) {
    const int rt = item >> 3, n = item & 7;
    const bool samp = rt >= 128;
    LAS float* XC = (LAS float*)lds;
    LAS float* BB = (LAS float*)(lds + 34816);
    LAS unsigned char* XCB = lds + 69632;
    LAS unsigned char* WA = lds + 88064;
    LAS unsigned char* WX = lds + 97280;
    LAS float* SEGA = (LAS float*)(lds + 106496);
    LAS float* SEGB = (LAS float*)(lds + 108544);
    LAS float* PRM = (LAS float*)(lds + 110592);
    if (fill_prm) {
        const int r = tid >> 6, ch = tid & 63, cglob = l * 512 + n * 64 + ch;
        float v;
        if (r == 0) v = p->in[26][cglob]; else if (r == 1) v = p->in[28][cglob]; else if (r == 2) v = softplus_neg_(p->in[29][cglob]);
        else if (r == 3) v = p->in[24][cglob]; else v = p->in[23][(size_t)(l * 4 + 3 - (r - 4)) * 512 + n * 64 + ch];
        PRM[r * 64 + ch] = v;
        __syncthreads();
    }
    {
        const int i = tid >> 2, cgp = tid & 3, c = n * 64 + cgp * 16;
        const size_t row = (size_t)rt * 128 + i;
        int t, bb;
        if (!samp) { bb = rt >> 4; t = (rt & 15) * 128 + i; } else { bb = (rt - 128) * 32 + (i >> 2); t = i & 3; }
        float xv[16];
#pragma unroll
        for (int e4 = 0; e4 < 4; ++e4) { const f32x4 bq = *(const LAS f32x4*)(PRM + 3 * 64 + cgp * 16 + 4 * e4); xv[4 * e4] = bq[0]; xv[4 * e4 + 1] = bq[1]; xv[4 * e4 + 2] = bq[2]; xv[4 * e4 + 3] = bq[3]; }
#pragma unroll
        for (int k = 0; k < 4; ++k) {
            float lxv[16];
            { const u32x4 za = (k == 0) ? zin.a0 : (k == 1) ? zin.a1 : (k == 2) ? zin.a2 : zin.a3, zb = (k == 0) ? zin.b0 : (k == 1) ? zin.b1 : (k == 2) ? zin.b2 : zin.b3;
              float f0[8], f1[8]; unpack8(za, f0); unpack8(zb, f1);
#pragma unroll
              for (int e = 0; e < 8; ++e) { lxv[e] = f0[e]; lxv[8 + e] = f1[e]; } }
            if (t - k < 0) {
#pragma unroll
                for (int e = 0; e < 16; ++e) lxv[e] = 0.f;
                if (samp) { const float* sp = p->in[5] + ((size_t)(l * 128 + bb) * 3 + (3 + t - k)) * 512 + c;
#pragma unroll
                    for (int e4 = 0; e4 < 4; ++e4) { const f32x4 v = *(const f32x4*)(sp + 4 * e4); lxv[4 * e4] = v[0]; lxv[4 * e4 + 1] = v[1]; lxv[4 * e4 + 2] = v[2]; lxv[4 * e4 + 3] = v[3]; } }
            }
#pragma unroll
            for (int e4 = 0; e4 < 4; ++e4) { const f32x4 wq = *(const LAS f32x4*)(PRM + (4 + k) * 64 + cgp * 16 + 4 * e4);
                xv[4 * e4] += wq[0] * lxv[4 * e4]; xv[4 * e4 + 1] += wq[1] * lxv[4 * e4 + 1]; xv[4 * e4 + 2] += wq[2] * lxv[4 * e4 + 2]; xv[4 * e4 + 3] += wq[3] * lxv[4 * e4 + 3]; }
            if (k == 0) {
                float* so = nullptr;
                if (!samp) { if (t >= 2045) so = p->out + O_PLCONV + ((size_t)(l * 8 + bb) * 3 + (t - 2045)) * 512 + c; }
                else { if (t >= 1) so = p->out + O_SLCONV + ((size_t)(l * 128 + bb) * 3 + (t - 1)) * 512 + c; }
                if (so) {
#pragma unroll
                    for (int e = 0; e < 16; e += 4) *(f32x4*)(so + e) = (f32x4){lxv[e], lxv[e + 1], lxv[e + 2], lxv[e + 3]};
                }
            }
        }
#pragma unroll
        for (int e = 0; e < 16; e += 4) *(LAS f32x4*)(XC + i * 68 + cgp * 16 + e) = (f32x4){xv[e], xv[e + 1], xv[e + 2], xv[e + 3]};
        u32x4 w0, w1;
        w0.x = cvt_pk_bf16(xv[0], xv[1]); w0.y = cvt_pk_bf16(xv[2], xv[3]); w0.z = cvt_pk_bf16(xv[4], xv[5]); w0.w = cvt_pk_bf16(xv[6], xv[7]);
        w1.x = cvt_pk_bf16(xv[8], xv[9]); w1.y = cvt_pk_bf16(xv[10], xv[11]); w1.z = cvt_pk_bf16(xv[12], xv[13]); w1.w = cvt_pk_bf16(xv[14], xv[15]);
        *(LAS u32x4*)(XCB + i * 144 + cgp * 32) = w0; *(LAS u32x4*)(XCB + i * 144 + cgp * 32 + 16) = w1;
        const int j = tid >> 3, ch = tid & 7;
        *(LAS u32x4*)(WA + j * 144 + ch * 16) = *(const u32x4*)(LWA + (size_t)j * 512 + n * 64 + ch * 8);
        *(LAS u32x4*)(WX + j * 144 + ch * 16) = *(const u32x4*)(LWX + (size_t)j * 512 + n * 64 + ch * 8);
    }
    __syncthreads();
    {
        const int lane = tid & 63, w = tid >> 6, fr = lane & 15, fq = lane >> 4;
        bf16x8 af[2];
#pragma unroll
        for (int ks = 0; ks < 2; ++ks) af[ks] = *(const LAS bf16x8*)(XCB + (16 * w + fr) * 144 + (32 * ks + 8 * fq) * 2);
        f32x4 ra[4], ri[4];
#pragma unroll
        for (int nt = 0; nt < 4; ++nt) { ra[nt] = (f32x4){0.f, 0.f, 0.f, 0.f}; ri[nt] = (f32x4){0.f, 0.f, 0.f, 0.f}; }
#pragma unroll
        for (int nt = 0; nt < 4; ++nt)
#pragma unroll
            for (int ks = 0; ks < 2; ++ks) {
                const bf16x8 wa = *(const LAS bf16x8*)(WA + (16 * nt + fr) * 144 + (32 * ks + 8 * fq) * 2);
                const bf16x8 wx = *(const LAS bf16x8*)(WX + (16 * nt + fr) * 144 + (32 * ks + 8 * fq) * 2);
                ra[nt] = __builtin_amdgcn_mfma_f32_16x16x32_bf16(wa, af[ks], ra[nt], 0, 0, 0);
                ri[nt] = __builtin_amdgcn_mfma_f32_16x16x32_bf16(wx, af[ks], ri[nt], 0, 0, 0);
            }
#pragma unroll
        for (int nt = 0; nt < 4; ++nt) {
            const int chn = 16 * nt + 4 * fq;
            LAS f32x4* xp = (LAS f32x4*)(XC + (16 * w + fr) * 68 + chn);
            const f32x4 xc4 = *xp;
            const f32x4 ba4 = *(const LAS f32x4*)(PRM + chn), bx4 = *(const LAS f32x4*)(PRM + 64 + chn), sp4 = *(const LAS f32x4*)(PRM + 128 + chn);
            f32x4 a4, b4;
#pragma unroll
            for (int j = 0; j < 4; ++j) {
                const float r = sigmoidf_(ra[nt][j] + ba4[j]), ig = sigmoidf_(ri[nt][j] + bx4[j]);
                const float la = -8.0f * r * sp4[j];
                a4[j] = __expf(la);
                b4[j] = __builtin_amdgcn_sqrtf(one_minus_exp_(2.0f * la)) * ig * xc4[j];
            }
            *xp = a4; *(LAS f32x4*)(BB + (16 * w + fr) * 68 + chn) = b4;
        }
    }
    __syncthreads();
    const int c = tid & 63, sg = tid >> 6;
    if (!samp) {
        float A = 1.f, B = 0.f;
#pragma unroll
        for (int tt = 0; tt < 16; ++tt) { const float a = XC[(16 * sg + tt) * 68 + c], b = BB[(16 * sg + tt) * 68 + c]; B = a * B + b; A *= a; }
        SEGA[sg * 64 + c] = A; SEGB[sg * 64 + c] = B;
    }
    __syncthreads();
    {
        float A = 1.f, B = 0.f;
        if (!samp) for (int s2 = 0; s2 < sg; ++s2) { const float sa = SEGA[s2 * 64 + c], sb = SEGB[s2 * 64 + c]; B = sa * B + sb; A *= sa; }
        const size_t base = ((size_t)rt * 128 + 16 * sg) * CW + n * 64 + c;
        if (!samp) {
#pragma unroll
            for (int tt = 0; tt < 16; ++tt) {
                const float a = XC[(16 * sg + tt) * 68 + c], b = BB[(16 * sg + tt) * 68 + c]; B = a * B + b; A *= a;
                const unsigned ab = cvt_pk_bf16(A, B);
                ((bf16_t*)ACUM)[base + (size_t)tt * CW] = (bf16_t)(ab & 0xffffu); ((bf16_t*)BCUM)[base + (size_t)tt * CW] = (bf16_t)(ab >> 16);
            }
            if (sg == 7) { float* ag = AGG + ((size_t)rt * 512 + n * 64 + c) * 2; ag[0] = A; ag[1] = B; }
        } else {
            float h = 0.f;
#pragma unroll
            for (int tt = 0; tt < 16; ++tt) {
                const int tok = 16 * sg + tt, bs = (rt - 128) * 32 + (tok >> 2);
                if ((tt & 3) == 0) h = p->in[6][(size_t)(l * 128 + bs) * 512 + n * 64 + c];
                const float a = XC[tok * 68 + c], b = BB[tok * 68 + c]; h = a * h + b;
                const size_t row = (size_t)rt * 128 + tok;
                const float lg = bf2f(Z[row * NIN + ZC_LG + n * 64 + c]);
                YB[row * (3 * CW) + n * 64 + c] = (bf16_t)(cvt_pk_bf16(h * lg, 0.f) & 0xffffu);
                if ((tt & 3) == 3) p->out[O_SH + (size_t)(l * 128 + bs) * 512 + n * 64 + c] = h;
            }
        }
    }
    __syncthreads();
}

__device__ __forceinline__ void conv_item(CP p, int l, const bf16_t* Z, bf16_t* YA, int ct, int tid) {
    const int rt = ct >> 2;
    const bool samp = rt >= 128;
#pragma unroll 2
    for (int it = 0; it < 4; ++it) {
        const int idx = it * 512 + tid, i = (ct & 3) * 32 + (idx >> 6), c = (idx & 63) * 8;
        const size_t row = (size_t)rt * 128 + i;
        int t, bb;
        if (!samp) { bb = rt >> 4; t = (rt & 15) * 128 + i; } else { bb = (rt - 128) * 32 + (i >> 2); t = i & 3; }
        u32x4 cvr[3], ccr[3]; f32x4 wq[3][2], stq[3][2];
#pragma unroll
        for (int k = 0; k < 3; ++k) { const size_t rk = (t - k >= 0) ? row - k : row; const bf16_t* zp = Z + rk * NIN; cvr[k] = *(const u32x4*)(zp + ZC_CV + c); ccr[k] = *(const u32x4*)(zp + ZC_CC + c); }
        const u32x4 cbr = *(const u32x4*)(Z + row * NIN + ZC_CB + c);
#pragma unroll
        for (int k = 0; k < 3; ++k) { const float* wp = p->in[21] + (size_t)(l * 3 + 2 - k) * 512 + c; wq[k][0] = *(const f32x4*)wp; wq[k][1] = *(const f32x4*)(wp + 4);
            stq[k][0] = (f32x4){0.f, 0.f, 0.f, 0.f}; stq[k][1] = stq[k][0]; }
        if (samp) {
#pragma unroll
            for (int k = 1; k < 3; ++k) { int si = 2 + t - k; si = si < 0 ? 0 : (si > 1 ? 1 : si);
                const float* sp = p->in[4] + ((size_t)(l * 128 + bb) * 2 + si) * 512 + c; stq[k][0] = *(const f32x4*)sp; stq[k][1] = *(const f32x4*)(sp + 4); }
        }
        float uacc[8];
#pragma unroll
        for (int e = 0; e < 8; ++e) uacc[e] = 0.f;
#pragma unroll
        for (int k = 0; k < 3; ++k) {
            float pv[8];
            { float a[8], bq[8]; unpack8(cvr[k], a); unpack8(ccr[k], bq);
#pragma unroll
              for (int e = 0; e < 8; ++e) pv[e] = a[e] * bq[e]; }
            if (t - k < 0) { pv[0] = stq[k][0][0]; pv[1] = stq[k][0][1]; pv[2] = stq[k][0][2]; pv[3] = stq[k][0][3]; pv[4] = stq[k][1][0]; pv[5] = stq[k][1][1]; pv[6] = stq[k][1][2]; pv[7] = stq[k][1][3]; }
            const f32x4 w0 = wq[k][0], w1 = wq[k][1];
            uacc[0] += w0[0] * pv[0]; uacc[1] += w0[1] * pv[1]; uacc[2] += w0[2] * pv[2]; uacc[3] += w0[3] * pv[3];
            uacc[4] += w1[0] * pv[4]; uacc[5] += w1[1] * pv[5]; uacc[6] += w1[2] * pv[6]; uacc[7] += w1[3] * pv[7];
            if (k == 0) {
                float* so = nullptr;
                if (!samp) { if (t >= 2046) so = p->out + O_PCONV + ((size_t)(l * 8 + bb) * 2 + (t - 2046)) * 512 + c; }
                else { if (t >= 2) so = p->out + O_SCONV + ((size_t)(l * 128 + bb) * 2 + (t - 2)) * 512 + c; }
                if (so) { *(f32x4*)so = (f32x4){pv[0], pv[1], pv[2], pv[3]}; *(f32x4*)(so + 4) = (f32x4){pv[4], pv[5], pv[6], pv[7]}; }
            }
        }
        float cbv[8]; unpack8(cbr, cbv);
        u32x4 wv; wv.x = cvt_pk_bf16(cbv[0] * uacc[0], cbv[1] * uacc[1]); wv.y = cvt_pk_bf16(cbv[2] * uacc[2], cbv[3] * uacc[3]);
        wv.z = cvt_pk_bf16(cbv[4] * uacc[4], cbv[5] * uacc[5]); wv.w = cvt_pk_bf16(cbv[6] * uacc[6], cbv[7] * uacc[7]);
        *(u32x4*)(YA + row * (3 * CW) + c) = wv;
    }
}

__device__ __forceinline__ void lru_apply_item(CP p, int l, const bf16_t* Z, const float* ACUM, const float* BCUM, const float* AGG, bf16_t* YB, int rt, int tid) {
    const bool samp = rt >= 128;
    const int c = (tid & 127) * 4, ro = tid >> 7;
    f32x4 carry = (f32x4){0.f, 0.f, 0.f, 0.f};
    const int bb0 = rt >> 4, jc = rt & 15;
    if (!samp) {
        f32x4 q0[15], q1[15];
#pragma unroll
        for (int jj = 0; jj < 15; ++jj) { const float* ag = AGG + ((size_t)(bb0 * 16 + (jj < jc ? jj : 0)) * 512 + c) * 2; q0[jj] = *(const f32x4*)ag; q1[jj] = *(const f32x4*)(ag + 4); }
#pragma unroll
        for (int jj = 0; jj < 15; ++jj) if (jj < jc) {
            carry[0] = q0[jj][0] * carry[0] + q0[jj][1]; carry[1] = q0[jj][2] * carry[1] + q0[jj][3]; carry[2] = q1[jj][0] * carry[2] + q1[jj][1]; carry[3] = q1[jj][2] * carry[3] + q1[jj][3]; }
    }
#pragma unroll 8
    for (int it = 0; it < 32; ++it) {
        const int i = ro + 4 * it; const size_t row = (size_t)rt * 128 + i;
        int bs = 0;
        if (samp) { bs = (rt - 128) * 32 + (i >> 2); carry = *(const f32x4*)(p->in[6] + (size_t)(l * 128 + bs) * 512 + c); }
        const u32x2 aw = *(const u32x2*)((const bf16_t*)ACUM + row * CW + c), bw = *(const u32x2*)((const bf16_t*)BCUM + row * CW + c);
        const f32x4 a4 = (f32x4){bf_lo(aw.x), bf_hi(aw.x), bf_lo(aw.y), bf_hi(aw.y)}, b4 = (f32x4){bf_lo(bw.x), bf_hi(bw.x), bf_lo(bw.y), bf_hi(bw.y)};
        const f32x4 h = a4 * carry + b4;
        const u32x2 gw = *(const u32x2*)(Z + row * NIN + ZC_LG + c);
        u32x2 wv; wv.x = cvt_pk_bf16(h[0] * bf_lo(gw.x), h[1] * bf_hi(gw.x)); wv.y = cvt_pk_bf16(h[2] * bf_lo(gw.y), h[3] * bf_hi(gw.y));
        *(u32x2*)(YB + row * (3 * CW) + c) = wv;
        if (!samp) { if (jc == 15 && i == 127) *(f32x4*)(p->out + O_PH + (size_t)(l * 8 + bb0) * 512 + c) = h; }
        else { if ((i & 3) == 3) *(f32x4*)(p->out + O_SH + (size_t)(l * 128 + bs) * 512 + c) = h; }
    }
}


#define XB_TMO      128
#define XB_XCNT(j)  (256  + 64 * (j))
#define XB_XSUB(j)  (1280 + 64 * (j))
#define XB_XGEN(j)  (2304 + 64 * (j))
#define XB_TOP      3328
#define XB_TOPGEN   3392
#define XCD_BAR_WORDS 3456
#define XB_SPIN_CAP (1u << 20)
__device__ __forceinline__ unsigned xb_ld(unsigned* p)              { return __hip_atomic_load(p, __ATOMIC_RELAXED, __HIP_MEMORY_SCOPE_AGENT); }
__device__ __forceinline__ unsigned xb_add(unsigned* p, unsigned v) { return __hip_atomic_fetch_add(p, v, __ATOMIC_RELAXED, __HIP_MEMORY_SCOPE_AGENT); }
__device__ __forceinline__ unsigned xb_xcc_id() { return (unsigned)__builtin_amdgcn_s_getreg((3 << 11) | 20) & 0xFu; }
#define XB_SPIN(cond, bar) do { unsigned _sp = 0; while (cond) { __builtin_amdgcn_s_sleep(1); \
    if ((++_sp & 255u) == 0u) { if (xb_ld(&(bar)[XB_TMO])) break; if (_sp > XB_SPIN_CAP) { atomicAdd(&(bar)[XB_TMO], 1u); break; } } } } while (0)
struct XcdBarrier { unsigned* bar; unsigned x; volatile LAS unsigned* st; };
__device__ __forceinline__ XcdBarrier xcd_barrier_post(unsigned* bar, volatile LAS unsigned* st) {
    XcdBarrier b; b.bar = bar; b.x = xb_xcc_id(); b.st = st;
    if (threadIdx.x == 0) (void)xb_add(&bar[XB_XCNT(b.x)], 1u);
    return b;
}
__device__ __forceinline__ void xcd_barrier_complete(unsigned* bar, unsigned x, unsigned& nloc, unsigned& nx) {
    const unsigned G = gridDim.x * gridDim.y * gridDim.z;
    unsigned sum, cnt, mine, sp = 0u;
    for (;;) {
        sum = 0u; cnt = 0u; mine = 0u;
#pragma unroll
        for (unsigned j = 0; j < 16; ++j) { const unsigned c = xb_ld(&bar[XB_XCNT(j)]); sum += c; cnt += (c > 0u) ? 1u : 0u; mine = (j == x) ? c : mine; }
        if (sum == G) break;
        __builtin_amdgcn_s_sleep(1);
        if ((++sp & 255u) == 0u) { if (xb_ld(&bar[XB_TMO])) break; if (sp > XB_SPIN_CAP) { atomicAdd(&bar[XB_TMO], 1u); break; } }
    }
    nloc = mine > 0u ? mine : 1u; nx = cnt > 0u ? cnt : 1u;
}
__device__ __forceinline__ void xcd_barrier(const XcdBarrier& b) {
    asm volatile("s_waitcnt vmcnt(0)" ::: "memory");
    __syncthreads();
    if (threadIdx.x == 0) {
        unsigned* bar = b.bar;
        __builtin_amdgcn_s_waitcnt(0);
        unsigned nloc = b.st[0], nx = b.st[1];
        if (nloc == 0u) { xcd_barrier_complete(bar, b.x, nloc, nx); b.st[0] = nloc; b.st[1] = nx; }
        const unsigned old = xb_add(&bar[XB_XSUB(b.x)], 1u);
        const unsigned gen = old / nloc;
        if (old + 1u == (gen + 1u) * nloc) {
            __builtin_amdgcn_fence(__ATOMIC_RELEASE, "agent");
            asm volatile("s_waitcnt vmcnt(0)" ::: "memory");
            const unsigned og = xb_add(&bar[XB_TOP], 1u);
            const unsigned tg = og / nx;
            if (og + 1u == (tg + 1u) * nx) xb_add(&bar[XB_TOPGEN], 1u);
            else XB_SPIN(xb_ld(&bar[XB_TOPGEN]) == tg, bar);
            __builtin_amdgcn_fence(__ATOMIC_ACQUIRE, "agent");
            xb_add(&bar[XB_XGEN(b.x)], 1u);
            asm volatile("s_waitcnt vmcnt(0)" ::: "memory");
        } else {
            XB_SPIN(xb_ld(&bar[XB_XGEN(b.x)]) == gen, bar);
            __builtin_amdgcn_fence(__ATOMIC_ACQUIRE, "agent");
            asm volatile("s_waitcnt vmcnt(0)" ::: "memory");
        }
    }
    __syncthreads();
}

#define WSP(q, off) ((q)->ws + (off))
__global__ void __launch_bounds__(512, 2) mega(Params p_unused) {
    extern __shared__ __attribute__((aligned(16))) unsigned char lds_raw[];
    LAS unsigned char* lds = (LAS unsigned char*)lds_raw;
    cg::grid_group grid = cg::this_grid();
    const int G = gridDim.x, blk = blockIdx.x;
    constexpr int LDS_ST = LDS_BYTES - 64;
    if (threadIdx.x < 16) ((volatile LAS unsigned*)(lds + LDS_ST))[threadIdx.x] = 0u;
    XcdBarrier xb;
    { CP p = kp(); xb = xcd_barrier_post((unsigned*)p->ws, (volatile LAS unsigned*)(lds + LDS_ST));
      if (p->ws == nullptr) grid.sync(); }
#define GRID_SYNC() xcd_barrier(xb)

    {
        CP p = kp(); const int tid = tid_(), lane = tid & 63, wave = __builtin_amdgcn_readfirstlane(tid >> 6);
        unsigned char* ws = p->ws;
        LAS float* scr = (LAS float*)(lds + wave * 16384);
        const int gw = blk * 8 + wave, NGW = G * 8;
        constexpr int I_F = 1408, I_IN = 3072, I_BR = 256, I_O = 512, I_LR = 16, I_KV = 256;
        constexpr int PER_L = 6 * I_F + I_IN + 3 * I_BR + I_O + 2 * I_LR + 2 * I_KV;
        bf16_t* WKV = (bf16_t*)(ws + WS_WKV);
        for (int it = gw; it < 2 * PER_L; it += NGW) {
            const int l = it / PER_L; int r = it - l * PER_L;
            unsigned char* wl = ws + WS_W + (size_t)l * WL_SIZE;
            const size_t fo = (size_t)l * D * FF;
            if (r < I_F) { transpose_item(p->in[14] + fo, FF, (bf16_t*)(wl + WL_GU1), D, 0, 1, scr, r, lane); continue; } r -= I_F;
            if (r < I_F) { transpose_item(p->in[15] + fo, FF, (bf16_t*)(wl + WL_GU1), D, 0, 2, scr, r, lane); continue; } r -= I_F;
            if (r < I_F) { transpose_item(p->in[16] + fo, D, (bf16_t*)(wl + WL_D1), FF, 0, 0, scr, r, lane); continue; } r -= I_F;
            if (r < I_F) { transpose_item(p->in[17] + fo, FF, (bf16_t*)(wl + WL_GU2), D, 0, 1, scr, r, lane); continue; } r -= I_F;
            if (r < I_F) { transpose_item(p->in[18] + fo, FF, (bf16_t*)(wl + WL_GU2), D, 0, 2, scr, r, lane); continue; } r -= I_F;
            if (r < I_F) { transpose_item(p->in[19] + fo, D, (bf16_t*)(wl + WL_D2), FF, 0, 0, scr, r, lane); continue; } r -= I_F;
            if (r < I_IN) { transpose_item(p->in[20] + (size_t)l * D * NIN, NIN, (bf16_t*)(wl + WL_IN), D, 0, 0, scr, r, lane); continue; } r -= I_IN;
            if (r < I_BR) { transpose_item(p->in[22] + (size_t)l * CW * D, D, (bf16_t*)(wl + WL_BR), 3 * CW, 0, 0, scr, r, lane); continue; } r -= I_BR;
            if (r < I_BR) { transpose_item(p->in[30] + (size_t)l * CW * D, D, (bf16_t*)(wl + WL_BR) + CW, 3 * CW, 0, 0, scr, r, lane); continue; } r -= I_BR;
            if (r < I_BR) { transpose_item(p->in[33] + (size_t)l * CW * D, D, (bf16_t*)(wl + WL_BR) + 2 * CW, 3 * CW, 0, 0, scr, r, lane); continue; } r -= I_BR;
            if (r < I_O) { transpose_item(p->in[34] + (size_t)l * D * D, D, (bf16_t*)(wl + WL_O), D, 0, 0, scr, r, lane); continue; } r -= I_O;
            if (r < I_LR) { transpose_item(p->in[25] + (size_t)l * 512 * 64, 64, (bf16_t*)(wl + WL_LWA), 512, 0, 0, scr, r, lane); continue; } r -= I_LR;
            if (r < I_LR) { transpose_item(p->in[27] + (size_t)l * 512 * 64, 64, (bf16_t*)(wl + WL_LWX), 512, 0, 0, scr, r, lane); continue; } r -= I_LR;
            if (r < I_KV) { transpose_item(p->in[31] + (size_t)l * D * CW, CW, WKV, D, l * 1024, 0, scr, r, lane); continue; } r -= I_KV;
            transpose_item(p->in[32] + (size_t)l * D * CW, CW, WKV, D, l * 1024 + 512, 0, scr, r, lane);
        }
        float* X = p->out + O_Y; bf16_t* XB = (bf16_t*)(ws + WS_XB); bf16_t* MEMB = (bf16_t*)(ws + WS_MEMB);
        for (int m = gw; m < T + 2048; m += NGW) {
            if (m < TP) row_cvt(p->in[0] + (size_t)m * D, nullptr, XB + (size_t)m * D, lane, 1.0f);
            else if (m < T) row_cvt(p->in[1] + (size_t)(m - TP) * D, nullptr, XB + (size_t)m * D, lane, 1.0f);
            else row_cvt(p->in[7] + (size_t)(m - T) * D, nullptr, MEMB + (size_t)(m - T) * D, lane, 1.0f);
        }
    }
    GRID_SYNC();

    {
        CP p = kp();
        pg8::Gemm g{(const bf16_t*)WSP(p, WS_MEMB), (const bf16_t*)WSP(p, WS_WKV), 2048, 2048, D}; pg8::StaticOrder S; S.init(2048, 2048, D, G, (blk + 84) % G);
        EpiKV E{p->out, (bf16_t*)WSP(p, WS_KMEM), (bf16_t*)WSP(p, WS_VT)};
        pg8::gemm_phase<EpiKV, pg8::StaticOrder>(lds, g, S, E);
    }

#pragma unroll 1
    for (int s = 0; s < 4; ++s) {
        const int l = s >> 1, half = s & 1;
        {
            CP p = kp(); unsigned char* wl = WSP(p, WS_W + (size_t)l * WL_SIZE);
            pg8::Gemm g{(const bf16_t*)WSP(p, WS_XB), (const bf16_t*)(wl + (half ? WL_GU2 : WL_GU1)), T, 2 * FF, D}; pg8::StaticOrder S; S.init(T, 2 * FF, D, G, blk);
            EpiGU E{(bf16_t*)WSP(p, WS_HZ)};
            pg8::gemm_phase<EpiGU, pg8::StaticOrder>(lds, g, S, E);
        }
        GRID_SYNC();
        {
            CP p = kp(); unsigned char* wl = WSP(p, WS_W + (size_t)l * WL_SIZE);
            pg8::Gemm g{(const bf16_t*)WSP(p, WS_HZ), (const bf16_t*)(wl + (half ? WL_D2 : WL_D1)), T, D, FF}; pg8::TailOrder S; S.init(D, FF, G, blk, 11);
            EpiRes<true> E; E.Xout = (s == 3) ? p->out + O_Y : nullptr; E.slab = (float*)WSP(p, WS_ACUM);
            E.lng = (half ? p->in[12] : p->in[8]) + l * D; E.lnb = (half ? p->in[13] : p->in[9]) + l * D; E.cnt = (unsigned*)p->ws + CW_CNT + s * 4096; E.nmini = 88;
            pg8::gemm_phase<EpiRes<true>, pg8::TailOrder>(lds, g, S, E);
        }
        if (blk >= G - 64) {
            CP p = kp(); const int tid = tid_(), lane = tid & 63, wave = __builtin_amdgcn_readfirstlane(tid >> 6);
            unsigned* sc = (unsigned*)p->ws + CW_CNT + s * 4096 + 32;
            if (wave == 0) { unsigned sp = 0; while ((unsigned)__builtin_amdgcn_readfirstlane(__hip_atomic_load(sc, __ATOMIC_RELAXED, __HIP_MEMORY_SCOPE_AGENT)) < (unsigned)G) { __builtin_amdgcn_s_sleep(2); if (++sp > (1u << 22)) break; }
                __builtin_amdgcn_fence(__ATOMIC_ACQUIRE, "agent"); asm volatile("s_waitcnt vmcnt(0)" ::: "memory"); }
            __syncthreads();
            const float* gp = (half ? p->in[12] : p->in[8]) + l * D; const float* bp = (half ? p->in[13] : p->in[9]) + l * D;
            const int m = TP + (blk - (G - 64)) * 8 + wave;
            ln_row<11>(s == 3 ? p->out + O_Y + (size_t)m * D : nullptr, (bf16_t*)WSP(p, WS_XB) + (size_t)m * D, gp, bp, lane, (const float*)WSP(p, WS_ACUM) + (size_t)(m - TP) * D);
        }
        if (s == 3) break;
        GRID_SYNC();
        if (half) continue;

        {
            CP p = kp(); unsigned char* wl = WSP(p, WS_W + (size_t)l * WL_SIZE);
            pg8::Gemm g{(const bf16_t*)WSP(p, WS_XB), (const bf16_t*)(wl + WL_IN), T, NIN, D}; pg8::StaticOrder S; S.init(T, NIN, D, G, blk);
            EpiZ E{(bf16_t*)WSP(p, WS_HZ)};
            pg8::gemm_phase<EpiZ, pg8::StaticOrder>(lds, g, S, E);
        }
        GRID_SYNC();
#pragma unroll 1
        for (int slot = 0; slot < 4; ++slot) {
            const int cat = (slot + ((blk & 1) << 1)) & 3;
            if (cat == 0) {
                for (int it = blk; it < 256; it += G) { CP p = kp();
                    attn_prompt_item(lds, (const bf16_t*)WSP(p, WS_HZ), (const bf16_t*)WSP(p, WS_KMEM) + (size_t)l * 2048 * 512, (const bf16_t*)WSP(p, WS_VT) + (size_t)l * 512 * 2048,
                                     (bf16_t*)WSP(p, WS_YBR) + 2 * CW, it, tid_()); }
            } else if (cat == 1) {
                for (int it = blk; it < 512; it += G) { CP p = kp();
                    attn_sample_item(lds, (const bf16_t*)WSP(p, WS_HZ), p->in[2] + (size_t)l * 128 * 256 * 512, p->in[3] + (size_t)l * 128 * 256 * 512,
                                     (bf16_t*)WSP(p, WS_YBR) + 2 * CW, it, tid_()); }
            } else if (cat == 2) {
                ZRows zcur;
                { CP p = kp(); zcur = lru_zload((const bf16_t*)WSP(p, WS_HZ), blk < 1056 ? blk : 0, tid_()); }
                for (int it = blk; it < 1056; it += G) { CP p = kp(); unsigned char* wl = WSP(p, WS_W + (size_t)l * WL_SIZE);
                    const ZRows znext = lru_zload((const bf16_t*)WSP(p, WS_HZ), it + G < 1056 ? it + G : it, tid_());
                    lru_item(lds, p, l, (const bf16_t*)WSP(p, WS_HZ), (const bf16_t*)(wl + WL_LWA), (const bf16_t*)(wl + WL_LWX),
                             (float*)WSP(p, WS_ACUM), (float*)WSP(p, WS_BCUM), (float*)WSP(p, WS_AGG), (bf16_t*)WSP(p, WS_YBR) + CW, it, tid_(), zcur, it == blk || (G & 7) != 0);
                    zcur = znext; }
            } else {
                for (int it = (G > 64 ? blk - 32 : blk); it >= 0 && it < 528; it += (G > 64 ? G - 32 : G)) { CP p = kp();
                    conv_item(p, l, (const bf16_t*)WSP(p, WS_HZ), (bf16_t*)WSP(p, WS_YBR), it, tid_()); }
            }
        }
        GRID_SYNC();
#pragma unroll 1
        for (int ph = 0; ph < 2; ++ph) {
            if (ph == 0) {
                for (int it = blk; it < 128; it += G) { CP p = kp();
                    lru_apply_item(p, l, (const bf16_t*)WSP(p, WS_HZ), (const float*)WSP(p, WS_ACUM), (const float*)WSP(p, WS_BCUM), (const float*)WSP(p, WS_AGG),
                                   (bf16_t*)WSP(p, WS_YBR) + CW, it, tid_()); }
            }
            if (ph == 1 && blk >= G - 64) {
                CP p = kp(); const int tid = tid_(), lane = tid & 63, wave = __builtin_amdgcn_readfirstlane(tid >> 6);
                const int m = (blk - (G - 64)) * 8 + wave;
                const float* sb = (const float*)WSP(p, WS_SLB3) + (size_t)m * D; bf16_t* mo = (bf16_t*)WSP(p, WS_MRG) + (size_t)(TP + m) * D;
#pragma unroll
                for (int j = 0; j < 4; ++j) { const f32x4 v = *((const f32x4*)sb + lane + 64 * j) + *((const f32x4*)(sb + (size_t)TS * D) + lane + 64 * j) + *((const f32x4*)(sb + 2 * (size_t)TS * D) + lane + 64 * j);
                    u32x2 w; w.x = cvt_pk_bf16(v[0], v[1]); w.y = cvt_pk_bf16(v[2], v[3]); *((u32x2*)mo + lane + 64 * j) = w; }
            }
            if (ph == 0 && blk >= G - 24) {
                CP p = kp(); unsigned char* wl = WSP(p, WS_W + (size_t)l * WL_SIZE);
                pg8::Gemm g{(const bf16_t*)WSP(p, WS_YBR), (const bf16_t*)(wl + WL_BR), T, D, 3 * CW}; pg8::ChainOrder S; S.init(TP, D, 3 * CW, G, blk, __builtin_amdgcn_readfirstlane(blk - (G - 24)));
                EpiBrS E{(float*)WSP(p, WS_SLB3), (const bf16_t*)WSP(p, WS_HZ) + ZC_GL};
                pg8::gemm_phase<EpiBrS, pg8::ChainOrder>(lds, g, S, E);
            }
            if (ph == 1) {
                CP p = kp(); unsigned char* wl = WSP(p, WS_W + (size_t)l * WL_SIZE);
                pg8::Gemm g{(const bf16_t*)WSP(p, WS_YBR), (const bf16_t*)(wl + WL_BR), T, D, 3 * CW}; pg8::ChainOrder S; S.init(TP, D, 3 * CW, G, blk, -1);
                EpiBr E{(bf16_t*)WSP(p, WS_MRG), (const bf16_t*)WSP(p, WS_HZ) + ZC_GL};
                pg8::gemm_phase<EpiBr, pg8::ChainOrder>(lds, g, S, E);
            }
            GRID_SYNC();
        }
        {
            CP p = kp(); unsigned char* wl = WSP(p, WS_W + (size_t)l * WL_SIZE);
            pg8::Gemm g{(const bf16_t*)WSP(p, WS_MRG), (const bf16_t*)(wl + WL_O), T, D, D}; pg8::TailOrder S; S.init(D, D, G, blk, 4);
            EpiRes<false> E; E.Xout = nullptr; E.slab = (float*)WSP(p, WS_ACUM);
            E.lng = p->in[10] + l * D; E.lnb = p->in[11] + l * D; E.cnt = (unsigned*)p->ws + CW_CNT + (4 + l) * 4096; E.nmini = 32;
            pg8::gemm_phase<EpiRes<false>, pg8::TailOrder>(lds, g, S, E);
        }
        if (blk >= G - 64) {
            CP p = kp(); const int tid = tid_(), lane = tid & 63, wave = __builtin_amdgcn_readfirstlane(tid >> 6);
            unsigned* sc = (unsigned*)p->ws + CW_CNT + (4 + l) * 4096 + 32;
            if (wave == 0) { unsigned sp = 0; while ((unsigned)__builtin_amdgcn_readfirstlane(__hip_atomic_load(sc, __ATOMIC_RELAXED, __HIP_MEMORY_SCOPE_AGENT)) < (unsigned)G) { __builtin_amdgcn_s_sleep(2); if (++sp > (1u << 22)) break; }
                __builtin_amdgcn_fence(__ATOMIC_ACQUIRE, "agent"); asm volatile("s_waitcnt vmcnt(0)" ::: "memory"); }
            __syncthreads();
            const int m = TP + (blk - (G - 64)) * 8 + wave;
            ln_row<4>(nullptr, (bf16_t*)WSP(p, WS_XB) + (size_t)m * D, p->in[10] + l * D, p->in[11] + l * D, lane, (const float*)WSP(p, WS_ACUM) + (size_t)(m - TP) * D);
        }
        GRID_SYNC();
    }
}

extern "C" void kernel_launch(void* const* d_in, const int* in_sizes, int n_in, void* d_out, int out_size, void* d_ws, size_t ws_size, hipStream_t stream) {
    static int grid_blocks = 0;
    if (!grid_blocks) {
        int dev = 0, cus = 0, per_cu = 0;
        (void)hipGetDevice(&dev);
        (void)hipDeviceGetAttribute(&cus, hipDeviceAttributeMultiprocessorCount, dev);
        (void)hipFuncSetAttribute((const void*)mega, hipFuncAttributeMaxDynamicSharedMemorySize, LDS_BYTES);
        (void)hipOccupancyMaxActiveBlocksPerMultiprocessor(&per_cu, (const void*)mega, 512, LDS_BYTES);
        if (per_cu < 1) per_cu = 1;
        grid_blocks = cus * per_cu;
        if (ws_size < WS_END) fprintf(stderr, "kernel_launch: workspace too small: %zu < %zu\n", ws_size, (size_t)WS_END);
    }
    Params p{};
    for (int i = 0; i < 35; ++i) p.in[i] = (const float*)d_in[i];
    p.out = (float*)d_out; p.ws = (unsigned char*)d_ws;
    void* args[] = {&p};
    (void)hipMemsetAsync(d_ws, 0, (size_t)CW_WORDS * 4, stream);
    hipError_t e = hipLaunchCooperativeKernel((const void*)mega, dim3(grid_blocks), dim3(512), args, LDS_BYTES, stream);
    if (e != hipSuccess) fprintf(stderr, "cooperative launch failed: %s (grid %d)\n", hipGetErrorString(e), grid_blocks);
}
```

```cpp
#include <hip/hip_runtime.h>
#include <hip/hip_cooperative_groups.h>
#include <cstdio>
namespace cg = cooperative_groups;

#define LAS __attribute__((address_space(3)))
typedef unsigned short bf16_t;
typedef short bf16x8 __attribute__((ext_vector_type(8)));
typedef float f32x4 __attribute__((ext_vector_type(4)));
typedef unsigned u32x4 __attribute__((ext_vector_type(4)));
typedef unsigned u32x2 __attribute__((ext_vector_type(2)));

constexpr int TP = 16384, TS = 512, T = TP + TS, D = 1024, FF = 2816, NIN = 6144, CW = 512;
constexpr int ZC_CV = 0, ZC_CB = 512, ZC_CC = 1024, ZC_LX = 1536, ZC_LG = 2048, ZC_Q = 2560, ZC_GL = 3072;
constexpr float ALPHA = 1.41421356237309515f, LN_EPS = 1e-5f;
constexpr int LDS_BYTES = 147456;
constexpr size_t O_Y = 0, O_PK = 17301504, O_PV = 19398656, O_PCONV = 21495808, O_PLCONV = 21512192, O_PH = 21536768,
                 O_SCONV = 21544960, O_SLCONV = 21807104, O_SH = 22200320;
constexpr size_t SZ_WGU = (size_t)2 * FF * D * 2, SZ_WD = (size_t)D * FF * 2, SZ_WIN = (size_t)NIN * D * 2, SZ_WBR = (size_t)D * CW * 2,
                 SZ_WO = (size_t)D * D * 2, SZ_LRUW = (size_t)64 * 512 * 2;
constexpr size_t WL_GU1 = 0, WL_D1 = WL_GU1 + SZ_WGU, WL_GU2 = WL_D1 + SZ_WD, WL_D2 = WL_GU2 + SZ_WGU, WL_IN = WL_D2 + SZ_WD,
                 WL_BR = WL_IN + SZ_WIN, WL_O = WL_BR + 3 * SZ_WBR, WL_LWA = WL_O + SZ_WO, WL_LWX = WL_LWA + SZ_LRUW, WL_SIZE = WL_LWX + SZ_LRUW;
constexpr size_t MiB = 1u << 20;
constexpr size_t WS_W = 1 * MiB, WS_WKV = WS_W + 2 * WL_SIZE, WS_MEMB = WS_WKV + 4 * MiB, WS_KMEM = WS_MEMB + 4 * MiB, WS_VT = WS_KMEM + 4 * MiB,
                 WS_XB = WS_VT + 4 * MiB, WS_HZ = WS_XB + (size_t)T * D * 2, WS_YBR = WS_HZ + (size_t)T * NIN * 2,
                 WS_ACUM = WS_YBR + 3 * (size_t)T * CW * 2, WS_BCUM = WS_ACUM + (size_t)T * CW * 4, WS_AGG = WS_BCUM + (size_t)T * CW * 4,
                 WS_MRG = WS_AGG + (size_t)132 * 512 * 2 * 4, WS_END = WS_MRG + (size_t)T * D * 2;
static_assert(WS_END < 565ull * 1000 * 1000, "workspace budget");
constexpr size_t WS_SLB3 = WS_ACUM + (size_t)T * CW * 2;
static_assert(WS_SLB3 + 3 * (size_t)TS * D * 4 <= WS_BCUM, "sample branch slabs fit behind the bf16 cumulants");

constexpr int CW_CNT = 4096, CW_WORDS = 4096 + 6 * 64 * 64;
constexpr size_t WS_XCH = 512 * 1024;
struct Params { const float* in[35]; float* out; unsigned char* ws; };
typedef const __attribute__((address_space(4))) Params* CP;
__device__ __forceinline__ CP kp() { CP q = (CP)__builtin_amdgcn_kernarg_segment_ptr(); asm volatile("" : "+s"(q)); return q; }
__device__ __forceinline__ int tid_() { int t = threadIdx.x; asm volatile("" : "+v"(t)); return t; }

__device__ __forceinline__ unsigned cvt_pk_bf16(float lo, float hi) { unsigned r; asm("v_cvt_pk_bf16_f32 %0, %1, %2" : "=v"(r) : "v"(lo), "v"(hi)); return r; }
__device__ __forceinline__ float bf_lo(unsigned u) { return __uint_as_float(u << 16); }
__device__ __forceinline__ float bf_hi(unsigned u) { return __uint_as_float(u & 0xffff0000u); }
__device__ __forceinline__ float bf2f(bf16_t b) { return __uint_as_float(((unsigned)b) << 16); }
__device__ __forceinline__ float sigmoidf_(float x) { return __builtin_amdgcn_rcpf(1.0f + __expf(-x)); }
__device__ __forceinline__ float silu_(float x) { return x * sigmoidf_(x); }
__device__ __forceinline__ float one_minus_exp_(float x) {
    const float ser = -x * (1.0f + x * (0.5f + x * (0.16666667f + x * (0.041666668f + x * (0.0083333338f + x * 0.0013888889f)))));
    return x > -0.25f ? ser : 1.0f - __expf(x);
}
__device__ __forceinline__ float softplus_neg_(float lam) {
    const float y = __expf(-lam);
    const float ser = y * (1.0f - y * (0.5f - y * (0.33333334f - y * 0.25f)));
    return y < 0.03f ? ser : __logf(1.0f + y);
}
__device__ __forceinline__ float gelu_tanh_(float x) { return x * sigmoidf_(1.5957691216057308f * (x + 0.044715f * x * x * x)); }
__device__ __forceinline__ float wave_sum(float v) {
#pragma unroll
    for (int o = 1; o < 64; o <<= 1) v += __shfl_xor(v, o);
    return v;
}
__device__ __forceinline__ float wave_max(float v) {
#pragma unroll
    for (int o = 1; o < 64; o <<= 1) v = fmaxf(v, __shfl_xor(v, o));
    return v;
}
__device__ __forceinline__ void unpack8(const u32x4 v, float (&f)[8]) {
    f[0] = bf_lo(v.x); f[1] = bf_hi(v.x); f[2] = bf_lo(v.y); f[3] = bf_hi(v.y); f[4] = bf_lo(v.z); f[5] = bf_hi(v.z); f[6] = bf_lo(v.w); f[7] = bf_hi(v.w);
}

namespace pg8 {
constexpr int BM = 256, BK = 64, HALF = 128, HTB = HALF * BK * 2, STAGE_BYTES = 8 * HTB, NXCD = 8, WGM = 8;
__device__ __forceinline__ int lds_byte(int r, int c) { const int st = (r >> 4) * 2 + (c >> 5), rr = r & 15, cc = c & 31, ob = rr * 64 + cc * 2; return st * 1024 + (ob ^ (((ob >> 9) & 1) << 5)); }
__device__ __forceinline__ void stage_rc(int b, int& R, int& C) { const int st = b / 1024, sb = b % 1024, swz = sb ^ (((sb >> 9) & 1) << 5); R = (st >> 1) * 16 + swz / 64; C = (st & 1) * 32 + (swz % 64) / 2; }
__device__ __forceinline__ int perm32(int rho) { const int n = rho >> 4, i = rho & 15; return 8 * (i >> 2) + 4 * n + (i & 3); }
struct Unit { int pm, pn, k0, nkt; };
struct Gemm { const bf16_t* A; const bf16_t* Bt; int M, N, K; };
struct StaticOrder {
    int nM, nN, nwg, G, c, kt;
    __device__ __forceinline__ void init(int M, int N, int K, int G_, int c_) { nM = M / BM; nN = N / BM; nwg = nM * nN; G = G_; c = c_; kt = K / BK; }
    __device__ __forceinline__ bool next(int i, int& pm, int& pn, int& k0, int& nkt) const {
        const int L = i * G + c; k0 = 0; nkt = kt; pm = 0; pn = 0;
        if (L >= nwg) return false;
        int wgid = L; { const int q = nwg / NXCD, r = nwg % NXCD, xcd = wgid % NXCD, off = wgid / NXCD; wgid = (xcd < r ? xcd * (q + 1) : r * (q + 1) + (xcd - r) * q) + off; }
        const int nig = WGM * nN, gid = wgid / nig, fm = gid * WGM, gsz = (nM - fm) < WGM ? (nM - fm) : WGM;
        pm = fm + ((wgid % nig) % gsz); pn = (wgid % nig) / gsz; return true;
    }
};

struct TailOrder {
    StaticOrder P; int nsplit, ktm, nmini;
    __device__ __forceinline__ void init(int N, int K, int G_, int c_, int nsplit_) { P.init(16384, N, K, G_, c_); nsplit = nsplit_; ktm = (K / BK) / nsplit_; nmini = 2 * P.nN * nsplit_; }
    __device__ __forceinline__ bool next(int i, int& pm, int& pn, int& k0, int& nkt) const {
        const bool has_mini = P.c < nmini;
        if (has_mini && i == 0) { const int j = P.c, tile = j / nsplit, sp = j - tile * nsplit;
            pm = 64 + tile / P.nN; pn = tile % P.nN; k0 = sp * ktm; nkt = ktm; return true; }
        const int ip = has_mini ? i - 1 : i;
        const bool ok = P.next(0, pm, pn, k0, nkt);
        return ok && ip == 0;
    }
};

struct ChainOrder {
    StaticOrder P; int segk, sc;
    __device__ __forceinline__ void init(int M, int N, int K, int G_, int c_, int sc_) { P.init(M, N, K, G_, c_); segk = (K / BK) / 3; sc = sc_; }
    __device__ __forceinline__ bool next(int i, int& pm, int& pn, int& k0, int& nkt) const {
        const int r = i / 3, sg = i - 3 * r; int d0, d1;
        bool ok = P.next(r, pm, pn, d0, d1);
        k0 = sg * segk; nkt = segk;
        if (sc >= 0) { const int tile = sc / 3; pm = 64 + (tile >> 2); pn = tile & 3; k0 = (sc - 3 * tile) * segk; ok = (i == 0); }
        return ok;
    }
};

template <class Epi, class Sched>
__device__ __forceinline__ void gemm_phase(LAS unsigned char* lds, const Gemm g, const Sched& S, const Epi& E) {
    const int tid = tid_(), wid = __builtin_amdgcn_readfirstlane(tid >> 6), lane = tid & 63, wr = wid >> 2, wc = wid & 3, fr = lane & 15, fq = lane >> 4;
    const int K = g.K;
    unsigned voffA[2], voffB[2];
#pragma unroll
    for (int i = 0; i < 2; ++i) { int R, C; stage_rc(tid * 16 + i * 8192, R, C); const int Rb = Epi::PERM ? ((R & ~31) + perm32(R & 31)) : R;
        voffA[i] = (unsigned)(R * K + C) * 2u; voffB[i] = (unsigned)(Rb * K + C) * 2u; }
    const size_t kstep = (size_t)(BK * 2);
    const size_t hstep = (size_t)HALF * K * 2;
    const size_t tstep = 2 * hstep;
    const unsigned ldsw = (unsigned)wid * 1024u;
    const int aoff = lds_byte(wr * 64 + fr, fq * 8), boff = lds_byte(wc * 32 + fr, fq * 8);
#define PG8_SA(b, h) (((b) * 2 + (h)) * HTB)
#define PG8_SB(b, h) ((4 + (b) * 2 + (h)) * HTB)
#define PG8_STAGE(bufoff, gbase, voff) do { _Pragma("unroll") for (int _i = 0; _i < 2; ++_i) \
        __builtin_amdgcn_global_load_lds((const unsigned*)((const char*)(gbase) + (voff)[_i]), (LAS unsigned*)(lds + (bufoff) + ldsw + _i * 8192), 16, 0, 0); } while (0)
#define PG8_LDA(dst, b, h) do { _Pragma("unroll") for (int m = 0; m < 4; ++m) _Pragma("unroll") for (int k = 0; k < 2; ++k) dst[m][k] = *(const LAS bf16x8*)(lds + PG8_SA(b, h) + aoff + m * 2048 + k * 1024); } while (0)
#define PG8_LDB(dst, b, h) do { _Pragma("unroll") for (int n = 0; n < 2; ++n) _Pragma("unroll") for (int k = 0; k < 2; ++k) dst[n][k] = *(const LAS bf16x8*)(lds + PG8_SB(b, h) + boff + n * 2048 + k * 1024); } while (0)
#define PG8_MMA(ai, bj, At, Bt) do { __builtin_amdgcn_s_setprio(1); _Pragma("unroll") for (int m = 0; m < 4; ++m) _Pragma("unroll") for (int n = 0; n < 2; ++n) _Pragma("unroll") for (int k = 0; k < 2; ++k) \
        acc[ai][bj][m][n] = __builtin_amdgcn_mfma_f32_16x16x32_bf16(Bt[n][k], At[m][k], acc[ai][bj][m][n], 0, 0, 0); __builtin_amdgcn_s_setprio(0); } while (0)
#define PG8_WAIT_V(n) asm volatile("s_waitcnt vmcnt(" #n ")" ::: "memory")
#define PG8_WAIT_L(n) asm volatile("s_waitcnt lgkmcnt(" #n ")" ::: "memory")
#define PG8_BAR __builtin_amdgcn_s_barrier()
#define PG8_SCHED __builtin_amdgcn_sched_barrier(0)
    int cpm, cpn, ck0, cnk, npm, npn, nk0, nnk; int ui = 0;
    if (!S.next(0, cpm, cpn, ck0, cnk)) return;
    f32x4 acc[2][2][4][2];
#pragma unroll
    for (int a = 0; a < 2; ++a)
#pragma unroll
        for (int b = 0; b < 2; ++b)
#pragma unroll
            for (int m = 0; m < 4; ++m)
#pragma unroll
                for (int n = 0; n < 2; ++n) acc[a][b][m][n] = (f32x4){0.f, 0.f, 0.f, 0.f};
    bf16x8 At[4][2], B0[2][2], B1[2][2];
    const char* cA = (const char*)g.A + (size_t)cpm * tstep + (size_t)ck0 * kstep; const char* cB = (const char*)g.Bt + (size_t)cpn * tstep + (size_t)ck0 * kstep;
    PG8_STAGE(PG8_SB(0, 0), cB, voffB); PG8_STAGE(PG8_SA(0, 0), cA, voffA); PG8_STAGE(PG8_SB(0, 1), cB + hstep, voffB); PG8_STAGE(PG8_SA(0, 1), cA + hstep, voffA);
    if (wr == 1) PG8_BAR;
    PG8_WAIT_V(4); PG8_BAR;
    PG8_STAGE(PG8_SB(1, 0), cB + kstep, voffB); PG8_STAGE(PG8_SA(1, 0), cA + kstep, voffA); PG8_STAGE(PG8_SB(1, 1), cB + hstep + kstep, voffB);
    PG8_WAIT_V(6); PG8_BAR;
    for (;;) {
        const bool has_next = S.next(ui + 1, npm, npn, nk0, nnk);
        const char* nA = has_next ? (const char*)g.A + (size_t)npm * tstep + (size_t)nk0 * kstep : cA; const char* nB = has_next ? (const char*)g.Bt + (size_t)npn * tstep + (size_t)nk0 * kstep : cB;
        const int nt = cnk;
        for (int t = 0; t < nt; t += 2) {
            const bool last = (t == nt - 2);
            const char* a1 = cA + (size_t)(t + 1) * kstep;
            const char* a2 = last ? nA : cA + (size_t)(t + 2) * kstep; const char* b2 = last ? nB : cB + (size_t)(t + 2) * kstep;
            const char* a3 = a2 + kstep; const char* b3 = b2 + kstep;
            PG8_LDB(B0, 0, 0); PG8_SCHED; PG8_LDA(At, 0, 0); PG8_STAGE(PG8_SA(1, 1), a1 + hstep, voffA);
            PG8_WAIT_L(8); PG8_BAR; PG8_WAIT_L(0); PG8_MMA(0, 0, At, B0); PG8_BAR; PG8_SCHED;
            PG8_LDB(B1, 0, 1); PG8_STAGE(PG8_SB(0, 0), b2, voffB);
            PG8_BAR; PG8_WAIT_L(0); PG8_MMA(0, 1, At, B1); PG8_BAR;
            PG8_LDA(At, 0, 1); PG8_STAGE(PG8_SA(0, 0), a2, voffA);
            PG8_BAR; PG8_WAIT_L(0); PG8_MMA(1, 0, At, B0); PG8_BAR; PG8_SCHED;
            PG8_STAGE(PG8_SB(0, 1), b2 + hstep, voffB);
            PG8_WAIT_V(6); PG8_BAR; PG8_MMA(1, 1, At, B1); PG8_BAR;
            PG8_LDB(B0, 1, 0); PG8_SCHED; PG8_LDA(At, 1, 0); PG8_STAGE(PG8_SA(0, 1), a2 + hstep, voffA);
            PG8_WAIT_L(8); PG8_BAR; PG8_WAIT_L(0); PG8_MMA(0, 0, At, B0); PG8_BAR; PG8_SCHED;
            PG8_LDB(B1, 1, 1); PG8_STAGE(PG8_SB(1, 0), b3, voffB);
            PG8_BAR; PG8_WAIT_L(0); PG8_MMA(0, 1, At, B1); PG8_BAR;
            PG8_LDA(At, 1, 1); PG8_STAGE(PG8_SA(1, 0), a3, voffA);
            PG8_BAR; PG8_WAIT_L(0); PG8_MMA(1, 0, At, B0); PG8_BAR; PG8_SCHED;
            PG8_STAGE(PG8_SB(1, 1), b3 + hstep, voffB);
            PG8_WAIT_V(6); PG8_BAR; PG8_MMA(1, 1, At, B1); PG8_BAR;
        }
        if (has_next || !Epi::AFTER_DRAIN) { Unit cu; cu.pm = cpm; cu.pn = cpn; cu.k0 = ck0; cu.nkt = cnk; E(acc, cu, wr, wc, fr, fq); }
        if (!has_next) break;
        if (!(Epi::CHAIN && nk0 != 0)) {
#pragma unroll
        for (int a = 0; a < 2; ++a)
#pragma unroll
            for (int b = 0; b < 2; ++b)
#pragma unroll
                for (int m = 0; m < 4; ++m)
#pragma unroll
                    for (int n = 0; n < 2; ++n) acc[a][b][m][n] = (f32x4){0.f, 0.f, 0.f, 0.f};
        }
        cpm = npm; cpn = npn; ck0 = nk0; cnk = nnk; cA = nA; cB = nB; ++ui;
    }
    PG8_WAIT_V(0);
    if (wr == 0) PG8_BAR;
    PG8_BAR;
    if constexpr (Epi::AFTER_DRAIN) E.fused(acc, cpm, cpn, wr, wc, fr, fq, lds, wid, lane);
#undef PG8_SA
#undef PG8_SB
#undef PG8_STAGE
#undef PG8_LDA
#undef PG8_LDB
#undef PG8_MMA
#undef PG8_WAIT_V
#undef PG8_WAIT_L
#undef PG8_BAR
#undef PG8_SCHED
}
}
using pg8::Unit;
typedef f32x4 AccT[2][2][4][2];

struct EpiGU {
    static constexpr bool AFTER_DRAIN = false, CHAIN = false, PERM = true;
    bf16_t* H;
    __device__ __forceinline__ void operator()(AccT& acc, const Unit& u, int wr, int wc, int fr, int fq) const {
        const int row0 = u.pm * 256 + wr * 64 + fr, col0 = u.pn * 128 + wc * 32 + 8 * fq;
#pragma unroll
        for (int ai = 0; ai < 2; ++ai)
#pragma unroll
            for (int m = 0; m < 4; ++m) {
                bf16_t* rowp = H + (size_t)(row0 + ai * 128 + m * 16) * FF + col0;
                const f32x4 g0 = acc[ai][0][m][0], g1 = acc[ai][0][m][1], u0 = acc[ai][1][m][0], u1 = acc[ai][1][m][1];
                u32x4 w;
                w.x = cvt_pk_bf16(silu_(g0[0]) * u0[0], silu_(g0[1]) * u0[1]); w.y = cvt_pk_bf16(silu_(g0[2]) * u0[2], silu_(g0[3]) * u0[3]);
                w.z = cvt_pk_bf16(silu_(g1[0]) * u1[0], silu_(g1[1]) * u1[1]); w.w = cvt_pk_bf16(silu_(g1[2]) * u1[2], silu_(g1[3]) * u1[3]);
                *(u32x4*)rowp = w;
            }
    }
};
__device__ __forceinline__ void panel_stats_run(unsigned* xbuf, unsigned* cnt, const AccT& v, const int upm, const int upn, int wr, int wc, int fr, int fq, LAS unsigned char* lds, int wid, int lane) {
    {
        typedef float f32x2v __attribute__((ext_vector_type(2)));
        LAS f32x2v* Pt = (LAS f32x2v*)lds;
        LAS f32x2v* St = (LAS f32x2v*)(lds + 8192);
#pragma unroll
        for (int ai = 0; ai < 2; ++ai)
#pragma unroll
            for (int m = 0; m < 4; ++m) {
                float s = 0.f;
#pragma unroll
                for (int bj = 0; bj < 2; ++bj)
#pragma unroll
                    for (int n = 0; n < 2; ++n) { const f32x4 x = v[ai][bj][m][n]; s += (x[0] + x[1]) + (x[2] + x[3]); }
                s += __shfl_xor(s, 16); s += __shfl_xor(s, 32);
                const float mw = s * (1.0f / 64.0f); float q = 0.f;
#pragma unroll
                for (int bj = 0; bj < 2; ++bj)
#pragma unroll
                    for (int n = 0; n < 2; ++n) { const f32x4 d = v[ai][bj][m][n] - mw; q += (d[0] * d[0] + d[1] * d[1]) + (d[2] * d[2] + d[3] * d[3]); }
                q += __shfl_xor(q, 16); q += __shfl_xor(q, 32);
                if (fq == 0) Pt[(ai * 128 + wr * 64 + m * 16 + fr) * 4 + wc] = (f32x2v){mw, q};
                __builtin_amdgcn_sched_barrier(0);
            }
        asm volatile("s_waitcnt lgkmcnt(0)" ::: "memory"); __builtin_amdgcn_s_barrier(); asm volatile("" ::: "memory");
        const int row = wid * 32 + (lane & 31);
        if (lane < 32) {
            const f32x2v a = Pt[row * 4 + 0], b = Pt[row * 4 + 1], c = Pt[row * 4 + 2], d = Pt[row * 4 + 3];
            const float mt = (a.x + b.x + c.x + d.x) * 0.25f;
            const float da = a.x - mt, db = b.x - mt, dc = c.x - mt, dd = d.x - mt;
            const float m2 = (a.y + b.y) + (c.y + d.y) + 64.0f * ((da * da + db * db) + (dc * dc + dd * dd));
            unsigned long long* slot = (unsigned long long*)xbuf + ((size_t)(upm * 256 + row) * 4 + upn);
            __hip_atomic_store(slot, ((unsigned long long)__float_as_uint(m2) << 32) | __float_as_uint(mt), __ATOMIC_RELAXED, __HIP_MEMORY_SCOPE_AGENT);
        }
        asm volatile("s_waitcnt vmcnt(0)" ::: "memory");
        if (lane == 0) __hip_atomic_fetch_add(cnt + 64 * upm, 1u, __ATOMIC_RELAXED, __HIP_MEMORY_SCOPE_AGENT);
        if (wid == 0) {
            unsigned sp = 0;
            while ((unsigned)__builtin_amdgcn_readfirstlane(__hip_atomic_load(cnt + 64 * upm, __ATOMIC_RELAXED, __HIP_MEMORY_SCOPE_AGENT)) < 32u) {
                __builtin_amdgcn_s_sleep(2); if (++sp > (1u << 22)) break; }
            __builtin_amdgcn_fence(__ATOMIC_ACQUIRE, "agent");
        }
        asm volatile("s_waitcnt vmcnt(0) lgkmcnt(0)" ::: "memory"); __builtin_amdgcn_s_barrier(); asm volatile("" ::: "memory");
        if (lane < 32) {
            const unsigned long long* slot = (const unsigned long long*)xbuf + (size_t)(upm * 256 + row) * 4; float mt[4], m2[4]; float ms = 0.f;
#pragma unroll
            for (int t = 0; t < 4; ++t) { const unsigned long long w = __hip_atomic_load(slot + t, __ATOMIC_RELAXED, __HIP_MEMORY_SCOPE_AGENT); mt[t] = __uint_as_float((unsigned)w); m2[t] = __uint_as_float((unsigned)(w >> 32)); ms += mt[t]; }
            const float mean = ms * 0.25f; float q = 0.f;
#pragma unroll
            for (int t = 0; t < 4; ++t) { const float dm = mt[t] - mean; q += m2[t] + 256.0f * dm * dm; }
            St[row] = (f32x2v){mean, 1.0f / sqrtf(q * (1.0f / 1024.0f) + LN_EPS)};
        }
        asm volatile("s_waitcnt lgkmcnt(0)" ::: "memory"); __builtin_amdgcn_s_barrier(); asm volatile("" ::: "memory");
    }
}
template <bool HALF> struct EpiRes {
    static constexpr bool CHAIN = false, PERM = true, AFTER_DRAIN = true;
    static constexpr float scale = HALF ? 0.5f : 1.0f;
    float* Xout; float* slab; const float* lng; const float* lnb; unsigned* cnt; int nmini;
    __device__ __forceinline__ void operator()(AccT& acc, const Unit& u, int wr, int wc, int fr, int fq) const {
        const int row0 = u.pm * 256 + wr * 64 + fr, col0 = u.pn * 256 + wc * 32 + 8 * fq;
        const int sp = u.k0 / u.nkt;
        float* base = slab + ((size_t)sp * TS + (row0 - TP)) * D + col0;
#pragma unroll
        for (int ai = 0; ai < 2; ++ai)
#pragma unroll
            for (int m = 0; m < 4; ++m)
#pragma unroll
                for (int bj = 0; bj < 2; ++bj) { float* pp = base + (size_t)(ai * 128 + m * 16) * D + bj * 128;
                    *(f32x4*)pp = acc[ai][bj][m][0] * scale; *(f32x4*)(pp + 4) = acc[ai][bj][m][1] * scale; }
    }
    __device__ __forceinline__ void fused(AccT& acc, const int upm, const int upn, int, int, int, int, LAS unsigned char* lds, int, int) const {
        typedef float f32x2v __attribute__((ext_vector_type(2)));
        const int tid2 = tid_(), wid = __builtin_amdgcn_readfirstlane(tid2 >> 6), lane = tid2 & 63, wr = wid >> 2, wc = wid & 3, fr = lane & 15, fq = lane >> 4;
        const int row0 = upm * 256 + wr * 64 + fr, col0 = upn * 256 + wc * 32 + 8 * fq;
        bf16_t* XB = (bf16_t*)((unsigned char*)slab - (WS_ACUM - WS_XB)); unsigned* xbuf = (unsigned*)((unsigned char*)slab - (WS_ACUM - WS_XCH));
        bf16_t* bb = XB + (size_t)row0 * D + col0;
        if (wid == 0) {
            if ((int)blockIdx.x < nmini) { __builtin_amdgcn_fence(__ATOMIC_RELEASE, "agent"); asm volatile("s_waitcnt vmcnt(0)" ::: "memory"); }
            if (lane == 0) __hip_atomic_fetch_add(cnt + 32, 1u, __ATOMIC_RELAXED, __HIP_MEMORY_SCOPE_AGENT);
        }
        {
            u32x4 v[2][4][2];
#pragma unroll
            for (int ai = 0; ai < 2; ++ai)
#pragma unroll
                for (int m = 0; m < 4; ++m)
#pragma unroll
                    for (int bj = 0; bj < 2; ++bj) v[ai][m][bj] = *(const u32x4*)(bb + (size_t)(ai * 128 + m * 16) * D + bj * 128);
#pragma unroll
            for (int ai = 0; ai < 2; ++ai) {
#pragma unroll
                for (int m = 0; m < 4; ++m)
#pragma unroll
                    for (int bj = 0; bj < 2; ++bj) { float x[8]; unpack8(v[ai][m][bj], x);
                        acc[ai][bj][m][0] = (f32x4){x[0], x[1], x[2], x[3]} * ALPHA + acc[ai][bj][m][0] * scale;
                        acc[ai][bj][m][1] = (f32x4){x[4], x[5], x[6], x[7]} * ALPHA + acc[ai][bj][m][1] * scale; }
#pragma unroll
                for (int m = 0; m < 4; ++m) asm volatile("" : "+v"(acc[ai][0][m][0]), "+v"(acc[ai][0][m][1]), "+v"(acc[ai][1][m][0]), "+v"(acc[ai][1][m][1]));
            }
            asm volatile("" ::: "memory");
        }
        panel_stats_run(xbuf, cnt, acc, upm, upn, wr, wc, fr, fq, lds, wid, lane);
        asm volatile("" ::: "memory");
        const LAS f32x2v* St = (const LAS f32x2v*)(lds + 8192);
        float* xo = Xout ? Xout + (size_t)row0 * D + col0 : nullptr;
        f32x4 gq[2][2], bq[2][2];
#pragma unroll
        for (int bj = 0; bj < 2; ++bj) { gq[bj][0] = *(const f32x4*)(lng + col0 + bj * 128); gq[bj][1] = *(const f32x4*)(lng + col0 + bj * 128 + 4);
            bq[bj][0] = *(const f32x4*)(lnb + col0 + bj * 128); bq[bj][1] = *(const f32x4*)(lnb + col0 + bj * 128 + 4); }
#pragma unroll
        for (int ai = 0; ai < 2; ++ai)
#pragma unroll
            for (int m = 0; m < 4; ++m) { const f32x2v sr = St[ai * 128 + wr * 64 + m * 16 + fr];
#pragma unroll
                for (int bj = 0; bj < 2; ++bj) { const size_t off = (size_t)(ai * 128 + m * 16) * D + bj * 128;
                    const f32x4 g0 = gq[bj][0], g1 = gq[bj][1], b0 = bq[bj][0], b1 = bq[bj][1];
                    const f32x4 y0 = (acc[ai][bj][m][0] - sr.x) * sr.y * g0 + b0, y1 = (acc[ai][bj][m][1] - sr.x) * sr.y * g1 + b1;
                    if (xo) { *(f32x4*)(xo + off) = y0; *(f32x4*)(xo + off + 4) = y1; }
                    u32x4 w; w.x = cvt_pk_bf16(y0[0], y0[1]); w.y = cvt_pk_bf16(y0[2], y0[3]); w.z = cvt_pk_bf16(y1[0], y1[1]); w.w = cvt_pk_bf16(y1[2], y1[3]); *(u32x4*)(bb + off) = w; }
                asm volatile("" ::: "memory"); }
    }
};
struct EpiZ {
    static constexpr bool AFTER_DRAIN = false, CHAIN = false, PERM = true;
    bf16_t* Z;
    __device__ __forceinline__ void operator()(AccT& acc, const Unit& u, int wr, int wc, int fr, int fq) const {
        const int row0 = u.pm * 256 + wr * 64 + fr, col0 = u.pn * 256 + wc * 32 + 8 * fq;
        const int mode = (u.pn >= 12) ? 2 : ((u.pn == 8 || u.pn == 9) ? 1 : 0);
#pragma unroll
        for (int ai = 0; ai < 2; ++ai)
#pragma unroll
            for (int m = 0; m < 4; ++m) {
                bf16_t* rowp = Z + (size_t)(row0 + ai * 128 + m * 16) * NIN + col0;
#pragma unroll
                for (int bj = 0; bj < 2; ++bj) {
                    f32x4 v0 = acc[ai][bj][m][0], v1 = acc[ai][bj][m][1];
                    if (mode == 2) {
#pragma unroll
                        for (int j = 0; j < 4; ++j) { v0[j] = sigmoidf_(v0[j]); v1[j] = sigmoidf_(v1[j]); }
                    } else if (mode == 1) {
#pragma unroll
                        for (int j = 0; j < 4; ++j) { v0[j] = gelu_tanh_(v0[j]); v1[j] = gelu_tanh_(v1[j]); }
                    }
                    u32x4 w; w.x = cvt_pk_bf16(v0[0], v0[1]); w.y = cvt_pk_bf16(v0[2], v0[3]); w.z = cvt_pk_bf16(v1[0], v1[1]); w.w = cvt_pk_bf16(v1[2], v1[3]);
                    *(u32x4*)(rowp + bj * 128) = w;
                }
            }
    }
};
struct EpiKV {
    static constexpr bool AFTER_DRAIN = false, CHAIN = false, PERM = false;
    float* out; bf16_t* KM; bf16_t* VT;
    __device__ __forceinline__ void operator()(AccT& acc, const Unit& u, int wr, int wc, int fr, int fq) const {
        const int l = u.pn >> 2, kv = (u.pn >> 1) & 1, half = u.pn & 1;
        float* ob = out + (kv ? O_PV : O_PK) + (size_t)l * 2048 * 512;
#pragma unroll
        for (int ai = 0; ai < 2; ++ai)
#pragma unroll
            for (int m = 0; m < 4; ++m) {
                const int r = u.pm * 256 + ai * 128 + wr * 64 + m * 16 + fr;
                const int k32 = r & 31, kc = k32 >> 2, pc = (kc < 4) ? 2 * kc : 2 * (kc - 4) + 1, pos = (r & ~31) + pc * 4 + (k32 & 3);
#pragma unroll
                for (int bj = 0; bj < 2; ++bj)
#pragma unroll
                    for (int n = 0; n < 2; ++n) {
                        const int cc = half * 256 + bj * 128 + wc * 32 + n * 16 + 4 * fq;
                        const f32x4 v = acc[ai][bj][m][n];
                        *(f32x4*)(ob + (size_t)r * 512 + cc) = v;
                        if (!kv) { u32x2 w; w.x = cvt_pk_bf16(v[0], v[1]); w.y = cvt_pk_bf16(v[2], v[3]); *(u32x2*)(KM + ((size_t)l * 2048 + r) * 512 + cc) = w; }
                        else {
                            const unsigned w0 = cvt_pk_bf16(v[0], v[1]), w1 = cvt_pk_bf16(v[2], v[3]);
                            bf16_t* vt = VT + ((size_t)l * 512 + cc) * 2048 + pos;
                            vt[0] = (bf16_t)(w0 & 0xffffu); vt[2048] = (bf16_t)(w0 >> 16); vt[4096] = (bf16_t)(w1 & 0xffffu); vt[6144] = (bf16_t)(w1 >> 16);
                        }
                    }
            }
    }
};
struct EpiBrS {
    static constexpr bool AFTER_DRAIN = false, CHAIN = false, PERM = true;
    float* slab3; const bf16_t* gate;
    __device__ __forceinline__ void operator()(AccT& acc, const Unit& u, int wr, int wc, int fr, int fq) const {
        const int sg = u.k0 / u.nkt;
        const int row0 = u.pm * 256 + wr * 64 + fr, col0 = u.pn * 256 + wc * 32 + 8 * fq;
        const bf16_t* gb = gate + (size_t)row0 * NIN + col0 + sg * D;
        float* sb = slab3 + ((size_t)sg * TS + (row0 - TP)) * D + col0;
#pragma unroll
        for (int ai = 0; ai < 2; ++ai)
#pragma unroll
            for (int m = 0; m < 4; ++m) {
                u32x4 gs[2];
#pragma unroll
                for (int bj = 0; bj < 2; ++bj) gs[bj] = *(const u32x4*)(gb + (size_t)(ai * 128 + m * 16) * NIN + bj * 128);
#pragma unroll
                for (int bj = 0; bj < 2; ++bj) { float nn[8]; unpack8(gs[bj], nn); float* pp = sb + (size_t)(ai * 128 + m * 16) * D + bj * 128;
                    f32x4 v0 = acc[ai][bj][m][0], v1 = acc[ai][bj][m][1];
                    v0[0] *= nn[0]; v0[1] *= nn[1]; v0[2] *= nn[2]; v0[3] *= nn[3]; v1[0] *= nn[4]; v1[1] *= nn[5]; v1[2] *= nn[6]; v1[3] *= nn[7];
                    *(f32x4*)pp = v0; *(f32x4*)(pp + 4) = v1; }
                asm volatile("" ::: "memory");
            }
    }
};
struct EpiBr {
    static constexpr bool AFTER_DRAIN = false, CHAIN = true, PERM = true;
    bf16_t* mrg; const bf16_t* gate;
    __device__ __forceinline__ void operator()(AccT& acc, const Unit& u, int wr, int wc, int fr, int fq) const {
        const int sg = u.k0 / u.nkt;
        const int row0 = u.pm * 256 + wr * 64 + fr, col0 = u.pn * 256 + wc * 32 + 8 * fq;
        const bf16_t* gb = gate + (size_t)row0 * NIN + col0 + sg * D; bf16_t* mb = mrg + (size_t)row0 * D + col0;
#pragma unroll
        for (int ai = 0; ai < 2; ++ai) {
            u32x4 gn[4][2], gd[4][2];
#pragma unroll
            for (int m = 0; m < 4; ++m)
#pragma unroll
                for (int bj = 0; bj < 2; ++bj) { const size_t ro = (size_t)(ai * 128 + m * 16); const int co = bj * 128;
                    gn[m][bj] = *(const u32x4*)(gb + ro * NIN + co);
                    if (sg < 2) gd[m][bj] = *(const u32x4*)(gb + ro * NIN + co + D); else gd[m][bj] = gn[m][bj]; }
#pragma unroll
            for (int m = 0; m < 4; ++m)
#pragma unroll
                for (int bj = 0; bj < 2; ++bj) { const size_t ro = (size_t)(ai * 128 + m * 16); const int co = bj * 128;
                    float nn[8], dd[8]; unpack8(gn[m][bj], nn); unpack8(gd[m][bj], dd);
#pragma unroll
                    for (int e = 0; e < 8; ++e) { nn[e] = fmaxf(nn[e], 1e-30f); if (sg < 2) nn[e] *= __builtin_amdgcn_rcpf(fmaxf(dd[e], 1e-30f)); }
                    f32x4 v0 = acc[ai][bj][m][0], v1 = acc[ai][bj][m][1];
                    v0[0] *= nn[0]; v0[1] *= nn[1]; v0[2] *= nn[2]; v0[3] *= nn[3]; v1[0] *= nn[4]; v1[1] *= nn[5]; v1[2] *= nn[6]; v1[3] *= nn[7];
                    if (sg < 2) { acc[ai][bj][m][0] = v0; acc[ai][bj][m][1] = v1; }
                    else { u32x4 w; w.x = cvt_pk_bf16(v0[0], v0[1]); w.y = cvt_pk_bf16(v0[2], v0[3]); w.z = cvt_pk_bf16(v1[0], v1[1]); w.w = cvt_pk_bf16(v1[2], v1[3]); *(u32x4*)(mb + ro * D + co) = w; } }
        }
    }
};

__device__ __forceinline__ void transpose_item(const float* W, int N, bf16_t* WT, int ldd, int row_off, int mode, LAS float* scr, int item, int lane) {
    const int nblk = N / 32, kb = item / nblk, nb = item % nblk, k0 = 64 * kb, n0 = 32 * nb;
    const int drow0 = (mode == 0) ? (row_off + n0) : (((n0 >> 7) << 8) + (n0 & 127) + (mode == 2 ? 128 : 0));
    float wv[32];
#pragma unroll
    for (int i = 0; i < 32; ++i) { const int kk = 2 * i + (lane >> 5); wv[i] = __builtin_nontemporal_load(W + (size_t)(k0 + kk) * N + n0 + (lane & 31)); }
#pragma unroll
    for (int i = 0; i < 32; ++i) { const int kk = 2 * i + (lane >> 5); scr[kk * 33 + (lane & 31)] = wv[i]; }
    asm volatile("s_waitcnt lgkmcnt(0)" ::: "memory");
    const int c = lane & 7;
#pragma unroll
    for (int j = 0; j < 4; ++j) { const int n = (lane >> 3) + 8 * j; const LAS float* s = scr + (8 * c) * 33 + n;
        u32x4 o; o.x = cvt_pk_bf16(s[0 * 33], s[1 * 33]); o.y = cvt_pk_bf16(s[2 * 33], s[3 * 33]); o.z = cvt_pk_bf16(s[4 * 33], s[5 * 33]); o.w = cvt_pk_bf16(s[6 * 33], s[7 * 33]);
        *(u32x4*)(WT + (size_t)(drow0 + n) * ldd + k0 + 8 * c) = o; }
    asm volatile("s_waitcnt lgkmcnt(0)" ::: "memory");
}

__device__ __forceinline__ void row_cvt(const float* src, float* dstf, bf16_t* dstb, int lane, float fscale) {
#pragma unroll
    for (int j = 0; j < 4; ++j) { const f32x4 v = __builtin_nontemporal_load((const f32x4*)src + lane + 64 * j); if (dstf) *((f32x4*)dstf + lane + 64 * j) = v * fscale;
        u32x2 w; w.x = cvt_pk_bf16(v[0], v[1]); w.y = cvt_pk_bf16(v[2], v[3]); *((u32x2*)dstb + lane + 64 * j) = w; }
}
template <int NSLAB>
__device__ __forceinline__ void ln_row(float* xout, bf16_t* brow, const float* g, const float* b, int lane, const float* slab) {
    f32x4 v[4]; float s = 0.f;
    u32x2 xw[4];
#pragma unroll
    for (int j = 0; j < 4; ++j) xw[j] = *((const u32x2*)brow + lane + 64 * j);
    f32x4 sv[NSLAB][4];
#pragma unroll
    for (int k = 0; k < NSLAB; ++k)
#pragma unroll
        for (int j = 0; j < 4; ++j) sv[k][j] = *((const f32x4*)(slab + (size_t)k * TS * D) + lane + 64 * j);
#pragma unroll
    for (int j = 0; j < 4; ++j) v[j] = (f32x4){bf_lo(xw[j].x), bf_hi(xw[j].x), bf_lo(xw[j].y), bf_hi(xw[j].y)} * ALPHA;
#pragma unroll
    for (int k = 0; k < NSLAB; ++k)
#pragma unroll
        for (int j = 0; j < 4; ++j) v[j] += sv[k][j];
#pragma unroll
    for (int j = 0; j < 4; ++j) s += (v[j][0] + v[j][1]) + (v[j][2] + v[j][3]);
    const float mean = wave_sum(s) * (1.f / D); float s2 = 0.f;
#pragma unroll
    for (int j = 0; j < 4; ++j) { v[j] = v[j] - mean; s2 += (v[j][0] * v[j][0] + v[j][1] * v[j][1]) + (v[j][2] * v[j][2] + v[j][3] * v[j][3]); }
    const float rstd = 1.0f / sqrtf(wave_sum(s2) * (1.f / D) + LN_EPS);
#pragma unroll
    for (int j = 0; j < 4; ++j) { const f32x4 gg = *((const f32x4*)g + lane + 64 * j), bb = *((const f32x4*)b + lane + 64 * j);
        const f32x4 y = v[j] * rstd * gg + bb; if (xout) *((f32x4*)xout + lane + 64 * j) = y;
        u32x2 w; w.x = cvt_pk_bf16(y[0], y[1]); w.y = cvt_pk_bf16(y[2], y[3]); *((u32x2*)brow + lane + 64 * j) = w; }
}

__device__ __forceinline__ void attn_prompt_item(LAS unsigned char* lds, const bf16_t* Z, const bf16_t* KM, const bf16_t* VT, bf16_t* YC, int item, int tid) {
    const int b = item >> 5, h = (item >> 3) & 3, qb = item & 7;
    const int lane = tid & 63, w = tid >> 6, fr = lane & 15, fq = lane >> 4;
    LAS unsigned char* Ks = lds; LAS unsigned char* Vs = lds + 69632;
#pragma unroll
    for (int it = 0; it < 8; ++it) { const int idx = it * 512 + tid, row = idx >> 4, ch = idx & 15;
        const u32x4 v = *(const u32x4*)(KM + (size_t)(b * 256 + row) * 512 + h * 128 + ch * 8); *(LAS u32x4*)(Ks + row * 272 + ch * 16) = v; }
#pragma unroll
    for (int it = 0; it < 8; ++it) { const int idx = it * 512 + tid, d = idx >> 5, ch = idx & 31;
        const u32x4 v = *(const u32x4*)(VT + (size_t)(h * 128 + d) * 2048 + b * 256 + ch * 8); *(LAS u32x4*)(Vs + d * 528 + ch * 16) = v; }
    const size_t qrow0 = (size_t)b * 2048 + qb * 256 + w * 32 + fr;
    bf16x8 qf[2][4];
#pragma unroll
    for (int mt = 0; mt < 2; ++mt)
#pragma unroll
        for (int kk = 0; kk < 4; ++kk) qf[mt][kk] = *(const bf16x8*)(Z + (qrow0 + 16 * mt) * NIN + ZC_Q + h * 128 + kk * 32 + fq * 8);
    __syncthreads();
    f32x4 s[2][16];
#pragma unroll
    for (int mt = 0; mt < 2; ++mt)
#pragma unroll
        for (int n = 0; n < 16; ++n) s[mt][n] = (f32x4){0.f, 0.f, 0.f, 0.f};
#pragma unroll
    for (int n = 0; n < 16; ++n)
#pragma unroll
        for (int kk = 0; kk < 4; ++kk) { const bf16x8 kf = *(const LAS bf16x8*)(Ks + (16 * n + fr) * 272 + (32 * kk + 8 * fq) * 2);
            s[0][n] = __builtin_amdgcn_mfma_f32_16x16x32_bf16(kf, qf[0][kk], s[0][n], 0, 0, 0);
            s[1][n] = __builtin_amdgcn_mfma_f32_16x16x32_bf16(kf, qf[1][kk], s[1][n], 0, 0, 0);
            if (kk == 3 && (n & 1)) __builtin_amdgcn_sched_barrier(0); }
    bf16x8 pf[2][8];
#pragma unroll
    for (int mt = 0; mt < 2; ++mt) {
        float mx = -3.0e38f;
#pragma unroll
        for (int n = 0; n < 16; ++n) mx = fmaxf(mx, fmaxf(fmaxf(s[mt][n][0], s[mt][n][1]), fmaxf(s[mt][n][2], s[mt][n][3])));
        mx = fmaxf(mx, __shfl_xor(mx, 16)); mx = fmaxf(mx, __shfl_xor(mx, 32));
        const float c2 = 0.08838834764831845f * 1.4426950408889634f; float sum = 0.f;
#pragma unroll
        for (int n = 0; n < 16; ++n)
#pragma unroll
            for (int j = 0; j < 4; ++j) { const float e = __builtin_amdgcn_exp2f((s[mt][n][j] - mx) * c2); s[mt][n][j] = e; sum += e; }
        sum += __shfl_xor(sum, 16); sum += __shfl_xor(sum, 32);
        const float inv = 1.0f / sum;
#pragma unroll
        for (int k2 = 0; k2 < 8; ++k2) { u32x4 t; t.x = cvt_pk_bf16(s[mt][2 * k2][0] * inv, s[mt][2 * k2][1] * inv); t.y = cvt_pk_bf16(s[mt][2 * k2][2] * inv, s[mt][2 * k2][3] * inv);
            t.z = cvt_pk_bf16(s[mt][2 * k2 + 1][0] * inv, s[mt][2 * k2 + 1][1] * inv); t.w = cvt_pk_bf16(s[mt][2 * k2 + 1][2] * inv, s[mt][2 * k2 + 1][3] * inv); pf[mt][k2] = __builtin_bit_cast(bf16x8, t); }
        __builtin_amdgcn_sched_barrier(0);
    }
    f32x4 o[2][8];
#pragma unroll
    for (int mt = 0; mt < 2; ++mt)
#pragma unroll
        for (int nd = 0; nd < 8; ++nd) o[mt][nd] = (f32x4){0.f, 0.f, 0.f, 0.f};
#pragma unroll
    for (int k2 = 0; k2 < 8; ++k2)
#pragma unroll
        for (int nd = 0; nd < 8; ++nd) { const bf16x8 vf = *(const LAS bf16x8*)(Vs + (16 * nd + fr) * 528 + (32 * k2 + 8 * fq) * 2);
            o[0][nd] = __builtin_amdgcn_mfma_f32_16x16x32_bf16(vf, pf[0][k2], o[0][nd], 0, 0, 0);
            o[1][nd] = __builtin_amdgcn_mfma_f32_16x16x32_bf16(vf, pf[1][k2], o[1][nd], 0, 0, 0);
            if (nd == 7) __builtin_amdgcn_sched_barrier(0); }
#pragma unroll
    for (int mt = 0; mt < 2; ++mt)
#pragma unroll
        for (int nd = 0; nd < 8; ++nd) { u32x2 wv; wv.x = cvt_pk_bf16(o[mt][nd][0], o[mt][nd][1]); wv.y = cvt_pk_bf16(o[mt][nd][2], o[mt][nd][3]);
            *(u32x2*)(YC + (qrow0 + 16 * mt) * (3 * CW) + h * 128 + 16 * nd + 4 * fq) = wv; }
    __syncthreads();
}

__device__ __forceinline__ void attn_sample_item(LAS unsigned char* lds, const bf16_t* Z, const float* CK, const float* CV, bf16_t* YC, int item, int tid) {
    const int b = item >> 2, h = item & 3;
    const int lane = tid & 63, w = tid >> 6;
    LAS float* S = (LAS float*)lds;
    LAS float* P = (LAS float*)(lds + 4096);
    LAS float* R = (LAS float*)(lds + 8192);
    {
        const int g = lane >> 4, i = lane & 15;
        u32x4 qraw[4];
#pragma unroll
        for (int qi = 0; qi < 4; ++qi) qraw[qi] = *(const u32x4*)(Z + (size_t)(TP + b * 4 + qi) * NIN + ZC_Q + h * 128 + 8 * i);
        const float* kbase = CK + ((size_t)(b * 256) * 4 + h) * 128 + 8 * i;
        f32x4 k0[8], k1[8];
#pragma unroll
        for (int it = 0; it < 8; ++it) { const int key = 32 * w + 4 * it + g; const float* pk = kbase + (size_t)key * 512; k0[it] = *(const f32x4*)pk; k1[it] = *(const f32x4*)(pk + 4); }
        float qv[4][8];
#pragma unroll
        for (int qi = 0; qi < 4; ++qi) unpack8(qraw[qi], qv[qi]);
#pragma unroll
        for (int it = 0; it < 8; ++it) { const int key = 32 * w + 4 * it + g;
#pragma unroll
            for (int qi = 0; qi < 4; ++qi) {
                float sv = k0[it][0] * qv[qi][0] + k0[it][1] * qv[qi][1] + k0[it][2] * qv[qi][2] + k0[it][3] * qv[qi][3]
                         + k1[it][0] * qv[qi][4] + k1[it][1] * qv[qi][5] + k1[it][2] * qv[qi][6] + k1[it][3] * qv[qi][7];
                sv += __shfl_xor(sv, 1); sv += __shfl_xor(sv, 2); sv += __shfl_xor(sv, 4); sv += __shfl_xor(sv, 8);
                if (i == 0) S[qi * 256 + key] = sv * 0.08838834764831845f;
            }
        }
    }
    __syncthreads();
    if (w < 4) {
        float v[4]; float mx = -3.0e38f;
#pragma unroll
        for (int j = 0; j < 4; ++j) { v[j] = S[w * 256 + lane + 64 * j]; mx = fmaxf(mx, v[j]); }
        mx = wave_max(mx); float sum = 0.f;
#pragma unroll
        for (int j = 0; j < 4; ++j) { v[j] = __expf(v[j] - mx); sum += v[j]; }
        sum = wave_sum(sum); const float inv = 1.0f / sum;
#pragma unroll
        for (int j = 0; j < 4; ++j) P[(lane + 64 * j) * 4 + w] = v[j] * inv;
    }
    {
        const int dq = tid & 31, kg = tid >> 5;
        const float* vbase = CV + ((size_t)(b * 256 + 16 * kg) * 4 + h) * 128 + 4 * dq;
        f32x4 vv[16];
#pragma unroll
        for (int key = 0; key < 16; ++key) vv[key] = *(const f32x4*)(vbase + (size_t)key * 512);
        __syncthreads();
        f32x4 a0 = (f32x4){0.f, 0.f, 0.f, 0.f}, a1 = a0, a2 = a0, a3 = a0;
#pragma unroll
        for (int key = 0; key < 16; ++key) { const f32x4 pp = *(const LAS f32x4*)(P + (16 * kg + key) * 4);
            a0 += vv[key] * pp[0]; a1 += vv[key] * pp[1]; a2 += vv[key] * pp[2]; a3 += vv[key] * pp[3]; }
        *(LAS f32x4*)(R + (kg * 4 + 0) * 128 + 4 * dq) = a0; *(LAS f32x4*)(R + (kg * 4 + 1) * 128 + 4 * dq) = a1;
        *(LAS f32x4*)(R + (kg * 4 + 2) * 128 + 4 * dq) = a2; *(LAS f32x4*)(R + (kg * 4 + 3) * 128 + 4 * dq) = a3;
    }
    __syncthreads();
    { const int qi = tid >> 7, d = tid & 127; float o = 0.f;
#pragma unroll
      for (int kg = 0; kg < 16; ++kg) o += R[(kg * 4 + qi) * 128 + d];
      YC[(size_t)(TP + b * 4 + qi) * (3 * CW) + h * 128 + d] = (bf16_t)(cvt_pk_bf16(o, 0.f) & 0xffffu); }
    __syncthreads();
}

struct ZRows { u32x4 a0, b0, a1, b1, a2, b2, a3, b3; };
__device__ __forceinline__ ZRows lru_zload(const bf16_t* Z, int item, int tid) {
    const int rt = item >> 3, n = item & 7, i = tid >> 2, c = n * 64 + (tid & 3) * 16;
    const size_t row = (size_t)rt * 128 + i;
    const int t = (rt < 128) ? (rt & 15) * 128 + i : (i & 3);
    const bf16_t* z0 = Z + row * NIN + ZC_LX + c;
    const bf16_t* z1 = (t >= 1) ? z0 - NIN : z0; const bf16_t* z2 = (t >= 2) ? z0 - 2 * NIN : z0; const bf16_t* z3 = (t >= 3) ? z0 - 3 * NIN : z0;
    ZRows r;
    r.a0 = *(const u32x4*)z0; r.b0 = *(const u32x4*)(z0 + 8); r.a1 = *(const u32x4*)z1; r.b1 = *(const u32x4*)(z1 + 8);
    r.a2 = *(const u32x4*)z2; r.b2 = *(const u32x4*)(z2 + 8); r.a3 = *(const u32x4*)z3; r.b3 = *(const u32x4*)(z3 + 8);
    return r;
}
__device__ __forceinline__ void lru_item(LAS unsigned char* lds, CP p, int l, const bf16_t* Z, const bf16_t* LWA, const bf16_t* LWX,
                                         float* ACUM, float* BCUM, float* AGG, bf16_t* YB, int item, int tid, const ZRows zin, bool fill_prm) {
    const int rt = item >> 3, n = item & 7;
    const bool samp = rt >= 128;
    LAS float* XC = (LAS float*)lds;
    LAS float* BB = (LAS float*)(lds + 34816);
    LAS unsigned char* XCB = lds + 69632;
    LAS unsigned char* WA = lds + 88064;
    LAS unsigned char* WX = lds + 97280;
    LAS float* SEGA = (LAS float*)(lds + 106496);
    LAS float* SEGB = (LAS float*)(lds + 108544);
    LAS float* PRM = (LAS float*)(lds + 110592);
    if (fill_prm) {
        const int r = tid >> 6, ch = tid & 63, cglob = l * 512 + n * 64 + ch;
        float v;
        if (r == 0) v = p->in[26][cglob]; else if (r == 1) v = p->in[28][cglob]; else if (r == 2) v = softplus_neg_(p->in[29][cglob]);
        else if (r == 3) v = p->in[24][cglob]; else v = p->in[23][(size_t)(l * 4 + 3 - (r - 4)) * 512 + n * 64 + ch];
        PRM[r * 64 + ch] = v;
        __syncthreads();
    }
    {
        const int i = tid >> 2, cgp = tid & 3, c = n * 64 + cgp * 16;
        const size_t row = (size_t)rt * 128 + i;
        int t, bb;
        if (!samp) { bb = rt >> 4; t = (rt & 15) * 128 + i; } else { bb = (rt - 128) * 32 + (i >> 2); t = i & 3; }
        float xv[16];
#pragma unroll
        for (int e4 = 0; e4 < 4; ++e4) { const f32x4 bq = *(const LAS f32x4*)(PRM + 3 * 64 + cgp * 16 + 4 * e4); xv[4 * e4] = bq[0]; xv[4 * e4 + 1] = bq[1]; xv[4 * e4 + 2] = bq[2]; xv[4 * e4 + 3] = bq[3]; }
#pragma unroll
        for (int k = 0; k < 4; ++k) {
            float lxv[16];
            { const u32x4 za = (k == 0) ? zin.a0 : (k == 1) ? zin.a1 : (k == 2) ? zin.a2 : zin.a3, zb = (k == 0) ? zin.b0 : (k == 1) ? zin.b1 : (k == 2) ? zin.b2 : zin.b3;
              float f0[8], f1[8]; unpack8(za, f0); unpack8(zb, f1);
#pragma unroll
              for (int e = 0; e < 8; ++e) { lxv[e] = f0[e]; lxv[8 + e] = f1[e]; } }
            if (t - k < 0) {
#pragma unroll
                for (int e = 0; e < 16; ++e) lxv[e] = 0.f;
                if (samp) { const float* sp = p->in[5] + ((size_t)(l * 128 + bb) * 3 + (3 + t - k)) * 512 + c;
#pragma unroll
                    for (int e4 = 0; e4 < 4; ++e4) { const f32x4 v = *(const f32x4*)(sp + 4 * e4); lxv[4 * e4] = v[0]; lxv[4 * e4 + 1] = v[1]; lxv[4 * e4 + 2] = v[2]; lxv[4 * e4 + 3] = v[3]; } }
            }
#pragma unroll
            for (int e4 = 0; e4 < 4; ++e4) { const f32x4 wq = *(const LAS f32x4*)(PRM + (4 + k) * 64 + cgp * 16 + 4 * e4);
                xv[4 * e4] += wq[0] * lxv[4 * e4]; xv[4 * e4 + 1] += wq[1] * lxv[4 * e4 + 1]; xv[4 * e4 + 2] += wq[2] * lxv[4 * e4 + 2]; xv[4 * e4 + 3] += wq[3] * lxv[4 * e4 + 3]; }
            if (k == 0) {
                float* so = nullptr;
                if (!samp) { if (t >= 2045) so = p->out + O_PLCONV + ((size_t)(l * 8 + bb) * 3 + (t - 2045)) * 512 + c; }
                else { if (t >= 1) so = p->out + O_SLCONV + ((size_t)(l * 128 + bb) * 3 + (t - 1)) * 512 + c; }
                if (so) {
#pragma unroll
                    for (int e = 0; e < 16; e += 4) *(f32x4*)(so + e) = (f32x4){lxv[e], lxv[e + 1], lxv[e + 2], lxv[e + 3]};
                }
            }
        }
#pragma unroll
        for (int e = 0; e < 16; e += 4) *(LAS f32x4*)(XC + i * 68 + cgp * 16 + e) = (f32x4){xv[e], xv[e + 1], xv[e + 2], xv[e + 3]};
        u32x4 w0, w1;
        w0.x = cvt_pk_bf16(xv[0], xv[1]); w0.y = cvt_pk_bf16(xv[2], xv[3]); w0.z = cvt_pk_bf16(xv[4], xv[5]); w0.w = cvt_pk_bf16(xv[6], xv[7]);
        w1.x = cvt_pk_bf16(xv[8], xv[9]); w1.y = cvt_pk_bf16(xv[10], xv[11]); w1.z = cvt_pk_bf16(xv[12], xv[13]); w1.w = cvt_pk_bf16(xv[14], xv[15]);
        *(LAS u32x4*)(XCB + i * 144 + cgp * 32) = w0; *(LAS u32x4*)(XCB + i * 144 + cgp * 32 + 16) = w1;
        const int j = tid >> 3, ch = tid & 7;
        *(LAS u32x4*)(WA + j * 144 + ch * 16) = *(const u32x4*)(LWA + (size_t)j * 512 + n * 64 + ch * 8);
        *(LAS u32x4*)(WX + j * 144 + ch * 16) = *(const u32x4*)(LWX + (size_t)j * 512 + n * 64 + ch * 8);
    }
    __syncthreads();
    {
        const int lane = tid & 63, w = tid >> 6, fr = lane & 15, fq = lane >> 4;
        bf16x8 af[2];
#pragma unroll
        for (int ks = 0; ks < 2; ++ks) af[ks] = *(const LAS bf16x8*)(XCB + (16 * w + fr) * 144 + (32 * ks + 8 * fq) * 2);
        f32x4 ra[4], ri[4];
#pragma unroll
        for (int nt = 0; nt < 4; ++nt) { ra[nt] = (f32x4){0.f, 0.f, 0.f, 0.f}; ri[nt] = (f32x4){0.f, 0.f, 0.f, 0.f}; }
#pragma unroll
        for (int nt = 0; nt < 4; ++nt)
#pragma unroll
            for (int ks = 0; ks < 2; ++ks) {
                const bf16x8 wa = *(const LAS bf16x8*)(WA + (16 * nt + fr) * 144 + (32 * ks + 8 * fq) * 2);
                const bf16x8 wx = *(const LAS bf16x8*)(WX + (16 * nt + fr) * 144 + (32 * ks + 8 * fq) * 2);
                ra[nt] = __builtin_amdgcn_mfma_f32_16x16x32_bf16(wa, af[ks], ra[nt], 0, 0, 0);
                ri[nt] = __builtin_amdgcn_mfma_f32_16x16x32_bf16(wx, af[ks], ri[nt], 0, 0, 0);
            }
#pragma unroll
        for (int nt = 0; nt < 4; ++nt) {
            const int chn = 16 * nt + 4 * fq;
            LAS f32x4* xp = (LAS f32x4*)(XC + (16 * w + fr) * 68 + chn);
            const f32x4 xc4 = *xp;
            const f32x4 ba4 = *(const LAS f32x4*)(PRM + chn), bx4 = *(const LAS f32x4*)(PRM + 64 + chn), sp4 = *(const LAS f32x4*)(PRM + 128 + chn);
            f32x4 a4, b4;
#pragma unroll
            for (int j = 0; j < 4; ++j) {
                const float r = sigmoidf_(ra[nt][j] + ba4[j]), ig = sigmoidf_(ri[nt][j] + bx4[j]);
                const float la = -8.0f * r * sp4[j];
                a4[j] = __expf(la);
                b4[j] = __builtin_amdgcn_sqrtf(one_minus_exp_(2.0f * la)) * ig * xc4[j];
            }
            *xp = a4; *(LAS f32x4*)(BB + (16 * w + fr) * 68 + chn) = b4;
        }
    }
    __syncthreads();
    const int c = tid & 63, sg = tid >> 6;
    if (!samp) {
        float A = 1.f, B = 0.f;
#pragma unroll
        for (int tt = 0; tt < 16; ++tt) { const float a = XC[(16 * sg + tt) * 68 + c], b = BB[(16 * sg + tt) * 68 + c]; B = a * B + b; A *= a; }
        SEGA[sg * 64 + c] = A; SEGB[sg * 64 + c] = B;
    }
    __syncthreads();
    {
        float A = 1.f, B = 0.f;
        if (!samp) for (int s2 = 0; s2 < sg; ++s2) { const float sa = SEGA[s2 * 64 + c], sb = SEGB[s2 * 64 + c]; B = sa * B + sb; A *= sa; }
        const size_t base = ((size_t)rt * 128 + 16 * sg) * CW + n * 64 + c;
        if (!samp) {
#pragma unroll
            for (int tt = 0; tt < 16; ++tt) {
                const float a = XC[(16 * sg + tt) * 68 + c], b = BB[(16 * sg + tt) * 68 + c]; B = a * B + b; A *= a;
                const unsigned ab = cvt_pk_bf16(A, B);
                ((bf16_t*)ACUM)[base + (size_t)tt * CW] = (bf16_t)(ab & 0xffffu); ((bf16_t*)BCUM)[base + (size_t)tt * CW] = (bf16_t)(ab >> 16);
            }
            if (sg == 7) { float* ag = AGG + ((size_t)rt * 512 + n * 64 + c) * 2; ag[0] = A; ag[1] = B; }
        } else {
            float h = 0.f;
#pragma unroll
            for (int tt = 0; tt < 16; ++tt) {
                const int tok = 16 * sg + tt, bs = (rt - 128) * 32 + (tok >> 2);
                if ((tt & 3) == 0) h = p->in[6][(size_t)(l * 128 + bs) * 512 + n * 64 + c];
                const float a = XC[tok * 68 + c], b = BB[tok * 68 + c]; h = a * h + b;
                const size_t row = (size_t)rt * 128 + tok;
                const float lg = bf2f(Z[row * NIN + ZC_LG + n * 64 + c]);
                YB[row * (3 * CW) + n * 64 + c] = (bf16_t)(cvt_pk_bf16(h * lg, 0.f) & 0xffffu);
                if ((tt & 3) == 3) p->out[O_SH + (size_t)(l * 128 + bs) * 512 + n * 64 + c] = h;
            }
        }
    }
    __syncthreads();
}

__device__ __forceinline__ void conv_item(CP p, int l, const bf16_t* Z, bf16_t* YA, int ct, int tid) {
    const int rt = ct >> 2;
    const bool samp = rt >= 128;
#pragma unroll 2
    for (int it = 0; it < 4; ++it) {
        const int idx = it * 512 + tid, i = (ct & 3) * 32 + (idx >> 6), c = (idx & 63) * 8;
        const size_t row = (size_t)rt * 128 + i;
        int t, bb;
        if (!samp) { bb = rt >> 4; t = (rt & 15) * 128 + i; } else { bb = (rt - 128) * 32 + (i >> 2); t = i & 3; }
        u32x4 cvr[3], ccr[3]; f32x4 wq[3][2], stq[3][2];
#pragma unroll
        for (int k = 0; k < 3; ++k) { const size_t rk = (t - k >= 0) ? row - k : row; const bf16_t* zp = Z + rk * NIN; cvr[k] = *(const u32x4*)(zp + ZC_CV + c); ccr[k] = *(const u32x4*)(zp + ZC_CC + c); }
        const u32x4 cbr = *(const u32x4*)(Z + row * NIN + ZC_CB + c);
#pragma unroll
        for (int k = 0; k < 3; ++k) { const float* wp = p->in[21] + (size_t)(l * 3 + 2 - k) * 512 + c; wq[k][0] = *(const f32x4*)wp; wq[k][1] = *(const f32x4*)(wp + 4);
            stq[k][0] = (f32x4){0.f, 0.f, 0.f, 0.f}; stq[k][1] = stq[k][0]; }
        if (samp) {
#pragma unroll
            for (int k = 1; k < 3; ++k) { int si = 2 + t - k; si = si < 0 ? 0 : (si > 1 ? 1 : si);
                const float* sp = p->in[4] + ((size_t)(l * 128 + bb) * 2 + si) * 512 + c; stq[k][0] = *(const f32x4*)sp; stq[k][1] = *(const f32x4*)(sp + 4); }
        }
        float uacc[8];
#pragma unroll
        for (int e = 0; e < 8; ++e) uacc[e] = 0.f;
#pragma unroll
        for (int k = 0; k < 3; ++k) {
            float pv[8];
            { float a[8], bq[8]; unpack8(cvr[k], a); unpack8(ccr[k], bq);
#pragma unroll
              for (int e = 0; e < 8; ++e) pv[e] = a[e] * bq[e]; }
            if (t - k < 0) { pv[0] = stq[k][0][0]; pv[1] = stq[k][0][1]; pv[2] = stq[k][0][2]; pv[3] = stq[k][0][3]; pv[4] = stq[k][1][0]; pv[5] = stq[k][1][1]; pv[6] = stq[k][1][2]; pv[7] = stq[k][1][3]; }
            const f32x4 w0 = wq[k][0], w1 = wq[k][1];
            uacc[0] += w0[0] * pv[0]; uacc[1] += w0[1] * pv[1]; uacc[2] += w0[2] * pv[2]; uacc[3] += w0[3] * pv[3];
            uacc[4] += w1[0] * pv[4]; uacc[5] += w1[1] * pv[5]; uacc[6] += w1[2] * pv[6]; uacc[7] += w1[3] * pv[7];
            if (k == 0) {
                float* so = nullptr;
                if (!samp) { if (t >= 2046) so = p->out + O_PCONV + ((size_t)(l * 8 + bb) * 2 + (t - 2046)) * 512 + c; }
                else { if (t >= 2) so = p->out + O_SCONV + ((size_t)(l * 128 + bb) * 2 + (t - 2)) * 512 + c; }
                if (so) { *(f32x4*)so = (f32x4){pv[0], pv[1], pv[2], pv[3]}; *(f32x4*)(so + 4) = (f32x4){pv[4], pv[5], pv[6], pv[7]}; }
            }
        }
        float cbv[8]; unpack8(cbr, cbv);
        u32x4 wv; wv.x = cvt_pk_bf16(cbv[0] * uacc[0], cbv[1] * uacc[1]); wv.y = cvt_pk_bf16(cbv[2] * uacc[2], cbv[3] * uacc[3]);
        wv.z = cvt_pk_bf16(cbv[4] * uacc[4], cbv[5] * uacc[5]); wv.w = cvt_pk_bf16(cbv[6] * uacc[6], cbv[7] * uacc[7]);
        *(u32x4*)(YA + row * (3 * CW) + c) = wv;
    }
}

__device__ __forceinline__ void lru_apply_item(CP p, int l, const bf16_t* Z, const float* ACUM, const float* BCUM, const float* AGG, bf16_t* YB, int rt, int tid) {
    const bool samp = rt >= 128;
    const int c = (tid & 127) * 4, ro = tid >> 7;
    f32x4 carry = (f32x4){0.f, 0.f, 0.f, 0.f};
    const int bb0 = rt >> 4, jc = rt & 15;
    if (!samp) {
        f32x4 q0[15], q1[15];
#pragma unroll
        for (int jj = 0; jj < 15; ++jj) { const float* ag = AGG + ((size_t)(bb0 * 16 + (jj < jc ? jj : 0)) * 512 + c) * 2; q0[jj] = *(const f32x4*)ag; q1[jj] = *(const f32x4*)(ag + 4); }
#pragma unroll
        for (int jj = 0; jj < 15; ++jj) if (jj < jc) {
            carry[0] = q0[jj][0] * carry[0] + q0[jj][1]; carry[1] = q0[jj][2] * carry[1] + q0[jj][3]; carry[2] = q1[jj][0] * carry[2] + q1[jj][1]; carry[3] = q1[jj][2] * carry[3] + q1[jj][3]; }
    }
#pragma unroll 8
    for (int it = 0; it < 32; ++it) {
        const int i = ro + 4 * it; const size_t row = (size_t)rt * 128 + i;
        int bs = 0;
        if (samp) { bs = (rt - 128) * 32 + (i >> 2); carry = *(const f32x4*)(p->in[6] + (size_t)(l * 128 + bs) * 512 + c); }
        const u32x2 aw = *(const u32x2*)((const bf16_t*)ACUM + row * CW + c), bw = *(const u32x2*)((const bf16_t*)BCUM + row * CW + c);
        const f32x4 a4 = (f32x4){bf_lo(aw.x), bf_hi(aw.x), bf_lo(aw.y), bf_hi(aw.y)}, b4 = (f32x4){bf_lo(bw.x), bf_hi(bw.x), bf_lo(bw.y), bf_hi(bw.y)};
        const f32x4 h = a4 * carry + b4;
        const u32x2 gw = *(const u32x2*)(Z + row * NIN + ZC_LG + c);
        u32x2 wv; wv.x = cvt_pk_bf16(h[0] * bf_lo(gw.x), h[1] * bf_hi(gw.x)); wv.y = cvt_pk_bf16(h[2] * bf_lo(gw.y), h[3] * bf_hi(gw.y));
        *(u32x2*)(YB + row * (3 * CW) + c) = wv;
        if (!samp) { if (jc == 15 && i == 127) *(f32x4*)(p->out + O_PH + (size_t)(l * 8 + bb0) * 512 + c) = h; }
        else { if ((i & 3) == 3) *(f32x4*)(p->out + O_SH + (size_t)(l * 128 + bs) * 512 + c) = h; }
    }
}


#define XB_TMO      128
#define XB_XCNT(j)  (256  + 64 * (j))
#define XB_XSUB(j)  (1280 + 64 * (j))
#define XB_XGEN(j)  (2304 + 64 * (j))
#define XB_TOP      3328
#define XB_TOPGEN   3392
#define XCD_BAR_WORDS 3456
#define XB_SPIN_CAP (1u << 20)
__device__ __forceinline__ unsigned xb_ld(unsigned* p)              { return __hip_atomic_load(p, __ATOMIC_RELAXED, __HIP_MEMORY_SCOPE_AGENT); }
__device__ __forceinline__ unsigned xb_add(unsigned* p, unsigned v) { return __hip_atomic_fetch_add(p, v, __ATOMIC_RELAXED, __HIP_MEMORY_SCOPE_AGENT); }
__device__ __forceinline__ unsigned xb_xcc_id() { return (unsigned)__builtin_amdgcn_s_getreg((3 << 11) | 20) & 0xFu; }
#define XB_SPIN(cond, bar) do { unsigned _sp = 0; while (cond) { __builtin_amdgcn_s_sleep(1); \
    if ((++_sp & 255u) == 0u) { if (xb_ld(&(bar)[XB_TMO])) break; if (_sp > XB_SPIN_CAP) { atomicAdd(&(bar)[XB_TMO], 1u); break; } } } } while (0)
struct XcdBarrier { unsigned* bar; unsigned x; volatile LAS unsigned* st; };
__device__ __forceinline__ XcdBarrier xcd_barrier_post(unsigned* bar, volatile LAS unsigned* st) {
    XcdBarrier b; b.bar = bar; b.x = xb_xcc_id(); b.st = st;
    if (threadIdx.x == 0) (void)xb_add(&bar[XB_XCNT(b.x)], 1u);
    return b;
}
__device__ __forceinline__ void xcd_barrier_complete(unsigned* bar, unsigned x, unsigned& nloc, unsigned& nx) {
    const unsigned G = gridDim.x * gridDim.y * gridDim.z;
    unsigned sum, cnt, mine, sp = 0u;
    for (;;) {
        sum = 0u; cnt = 0u; mine = 0u;
#pragma unroll
        for (unsigned j = 0; j < 16; ++j) { const unsigned c = xb_ld(&bar[XB_XCNT(j)]); sum += c; cnt += (c > 0u) ? 1u : 0u; mine = (j == x) ? c : mine; }
        if (sum == G) break;
        __builtin_amdgcn_s_sleep(1);
        if ((++sp & 255u) == 0u) { if (xb_ld(&bar[XB_TMO])) break; if (sp > XB_SPIN_CAP) { atomicAdd(&bar[XB_TMO], 1u); break; } }
    }
    nloc = mine > 0u ? mine : 1u; nx = cnt > 0u ? cnt : 1u;
}
__device__ __forceinline__ void xcd_barrier(const XcdBarrier& b) {
    asm volatile("s_waitcnt vmcnt(0)" ::: "memory");
    __syncthreads();
    if (threadIdx.x == 0) {
        unsigned* bar = b.bar;
        __builtin_amdgcn_s_waitcnt(0);
        unsigned nloc = b.st[0], nx = b.st[1];
        if (nloc == 0u) { xcd_barrier_complete(bar, b.x, nloc, nx); b.st[0] = nloc; b.st[1] = nx; }
        const unsigned old = xb_add(&bar[XB_XSUB(b.x)], 1u);
        const unsigned gen = old / nloc;
        if (old + 1u == (gen + 1u) * nloc) {
            __builtin_amdgcn_fence(__ATOMIC_RELEASE, "agent");
            asm volatile("s_waitcnt vmcnt(0)" ::: "memory");
            const unsigned og = xb_add(&bar[XB_TOP], 1u);
            const unsigned tg = og / nx;
            if (og + 1u == (tg + 1u) * nx) xb_add(&bar[XB_TOPGEN], 1u);
            else XB_SPIN(xb_ld(&bar[XB_TOPGEN]) == tg, bar);
            __builtin_amdgcn_fence(__ATOMIC_ACQUIRE, "agent");
            xb_add(&bar[XB_XGEN(b.x)], 1u);
            asm volatile("s_waitcnt vmcnt(0)" ::: "memory");
        } else {
            XB_SPIN(xb_ld(&bar[XB_XGEN(b.x)]) == gen, bar);
            __builtin_amdgcn_fence(__ATOMIC_ACQUIRE, "agent");
            asm volatile("s_waitcnt vmcnt(0)" ::: "memory");
        }
    }
    __syncthreads();
}

#define WSP(q, off) ((q)->ws + (off))
__global__ void __launch_bounds__(512, 2) mega(Params p_unused) {
    extern __shared__ __attribute__((aligned(16))) unsigned char lds_raw[];
    LAS unsigned char* lds = (LAS unsigned char*)lds_raw;
    cg::grid_group grid = cg::this_grid();
    const int G = gridDim.x, blk = blockIdx.x;
    constexpr int LDS_ST = LDS_BYTES - 64;
    if (threadIdx.x < 16) ((volatile LAS unsigned*)(lds + LDS_ST))[threadIdx.x] = 0u;
    XcdBarrier xb;
    { CP p = kp(); xb = xcd_barrier_post((unsigned*)p->ws, (volatile LAS unsigned*)(lds + LDS_ST));
      if (p->ws == nullptr) grid.sync(); }
#define GRID_SYNC() xcd_barrier(xb)

    {
        CP p = kp(); const int tid = tid_(), lane = tid & 63, wave = __builtin_amdgcn_readfirstlane(tid >> 6);
        unsigned char* ws = p->ws;
        LAS float* scr = (LAS float*)(lds + wave * 16384);
        const int gw = blk * 8 + wave, NGW = G * 8;
        constexpr int I_F = 1408, I_IN = 3072, I_BR = 256, I_O = 512, I_LR = 16, I_KV = 256;
        constexpr int PER_L = 6 * I_F + I_IN + 3 * I_BR + I_O + 2 * I_LR + 2 * I_KV;
        bf16_t* WKV = (bf16_t*)(ws + WS_WKV);
        for (int it = gw; it < 2 * PER_L; it += NGW) {
            const int l = it / PER_L; int r = it - l * PER_L;
            unsigned char* wl = ws + WS_W + (size_t)l * WL_SIZE;
            const size_t fo = (size_t)l * D * FF;
            if (r < I_F) { transpose_item(p->in[14] + fo, FF, (bf16_t*)(wl + WL_GU1), D, 0, 1, scr, r, lane); continue; } r -= I_F;
            if (r < I_F) { transpose_item(p->in[15] + fo, FF, (bf16_t*)(wl + WL_GU1), D, 0, 2, scr, r, lane); continue; } r -= I_F;
            if (r < I_F) { transpose_item(p->in[16] + fo, D, (bf16_t*)(wl + WL_D1), FF, 0, 0, scr, r, lane); continue; } r -= I_F;
            if (r < I_F) { transpose_item(p->in[17] + fo, FF, (bf16_t*)(wl + WL_GU2), D, 0, 1, scr, r, lane); continue; } r -= I_F;
            if (r < I_F) { transpose_item(p->in[18] + fo, FF, (bf16_t*)(wl + WL_GU2), D, 0, 2, scr, r, lane); continue; } r -= I_F;
            if (r < I_F) { transpose_item(p->in[19] + fo, D, (bf16_t*)(wl + WL_D2), FF, 0, 0, scr, r, lane); continue; } r -= I_F;
            if (r < I_IN) { transpose_item(p->in[20] + (size_t)l * D * NIN, NIN, (bf16_t*)(wl + WL_IN), D, 0, 0, scr, r, lane); continue; } r -= I_IN;
            if (r < I_BR) { transpose_item(p->in[22] + (size_t)l * CW * D, D, (bf16_t*)(wl + WL_BR), 3 * CW, 0, 0, scr, r, lane); continue; } r -= I_BR;
            if (r < I_BR) { transpose_item(p->in[30] + (size_t)l * CW * D, D, (bf16_t*)(wl + WL_BR) + CW, 3 * CW, 0, 0, scr, r, lane); continue; } r -= I_BR;
            if (r < I_BR) { transpose_item(p->in[33] + (size_t)l * CW * D, D, (bf16_t*)(wl + WL_BR) + 2 * CW, 3 * CW, 0, 0, scr, r, lane); continue; } r -= I_BR;
            if (r < I_O) { transpose_item(p->in[34] + (size_t)l * D * D, D, (bf16_t*)(wl + WL_O), D, 0, 0, scr, r, lane); continue; } r -= I_O;
            if (r < I_LR) { transpose_item(p->in[25] + (size_t)l * 512 * 64, 64, (bf16_t*)(wl + WL_LWA), 512, 0, 0, scr, r, lane); continue; } r -= I_LR;
            if (r < I_LR) { transpose_item(p->in[27] + (size_t)l * 512 * 64, 64, (bf16_t*)(wl + WL_LWX), 512, 0, 0, scr, r, lane); continue; } r -= I_LR;
            if (r < I_KV) { transpose_item(p->in[31] + (size_t)l * D * CW, CW, WKV, D, l * 1024, 0, scr, r, lane); continue; } r -= I_KV;
            transpose_item(p->in[32] + (size_t)l * D * CW, CW, WKV, D, l * 1024 + 512, 0, scr, r, lane);
        }
        float* X = p->out + O_Y; bf16_t* XB = (bf16_t*)(ws + WS_XB); bf16_t* MEMB = (bf16_t*)(ws + WS_MEMB);
        for (int m = gw; m < T + 2048; m += NGW) {
            if (m < TP) row_cvt(p->in[0] + (size_t)m * D, nullptr, XB + (size_t)m * D, lane, 1.0f);
            else if (m < T) row_cvt(p->in[1] + (size_t)(m - TP) * D, nullptr, XB + (size_t)m * D, lane, 1.0f);
            else row_cvt(p->in[7] + (size_t)(m - T) * D, nullptr, MEMB + (size_t)(m - T) * D, lane, 1.0f);
        }
    }
    GRID_SYNC();

    {
        CP p = kp();
        pg8::Gemm g{(const bf16_t*)WSP(p, WS_MEMB), (const bf16_t*)WSP(p, WS_WKV), 2048, 2048, D}; pg8::StaticOrder S; S.init(2048, 2048, D, G, (blk + 84) % G);
        EpiKV E{p->out, (bf16_t*)WSP(p, WS_KMEM), (bf16_t*)WSP(p, WS_VT)};
        pg8::gemm_phase<EpiKV, pg8::StaticOrder>(lds, g, S, E);
    }

#pragma unroll 1
    for (int s = 0; s < 4; ++s) {
        const int l = s >> 1, half = s & 1;
        {
            CP p = kp(); unsigned char* wl = WSP(p, WS_W + (size_t)l * WL_SIZE);
            pg8::Gemm g{(const bf16_t*)WSP(p, WS_XB), (const bf16_t*)(wl + (half ? WL_GU2 : WL_GU1)), T, 2 * FF, D}; pg8::StaticOrder S; S.init(T, 2 * FF, D, G, blk);
            EpiGU E{(bf16_t*)WSP(p, WS_HZ)};
            pg8::gemm_phase<EpiGU, pg8::StaticOrder>(lds, g, S, E);
        }
        GRID_SYNC();
        {
            CP p = kp(); unsigned char* wl = WSP(p, WS_W + (size_t)l * WL_SIZE);
            pg8::Gemm g{(const bf16_t*)WSP(p, WS_HZ), (const bf16_t*)(wl + (half ? WL_D2 : WL_D1)), T, D, FF}; pg8::TailOrder S; S.init(D, FF, G, blk, 11);
            EpiRes<true> E; E.Xout = (s == 3) ? p->out + O_Y : nullptr; E.slab = (float*)WSP(p, WS_ACUM);
            E.lng = (half ? p->in[12] : p->in[8]) + l * D; E.lnb = (half ? p->in[13] : p->in[9]) + l * D; E.cnt = (unsigned*)p->ws + CW_CNT + s * 4096; E.nmini = 88;
            pg8::gemm_phase<EpiRes<true>, pg8::TailOrder>(lds, g, S, E);
        }
        if (blk >= G - 64) {
            CP p = kp(); const int tid = tid_(), lane = tid & 63, wave = __builtin_amdgcn_readfirstlane(tid >> 6);
            unsigned* sc = (unsigned*)p->ws + CW_CNT + s * 4096 + 32;
            if (wave == 0) { unsigned sp = 0; while ((unsigned)__builtin_amdgcn_readfirstlane(__hip_atomic_load(sc, __ATOMIC_RELAXED, __HIP_MEMORY_SCOPE_AGENT)) < (unsigned)G) { __builtin_amdgcn_s_sleep(2); if (++sp > (1u << 22)) break; }
                __builtin_amdgcn_fence(__ATOMIC_ACQUIRE, "agent"); asm volatile("s_waitcnt vmcnt(0)" ::: "memory"); }
            __syncthreads();
            const float* gp = (half ? p->in[12] : p->in[8]) + l * D; const float* bp = (half ? p->in[13] : p->in[9]) + l * D;
            const int m = TP + (blk - (G - 64)) * 8 + wave;
            ln_row<11>(s == 3 ? p->out + O_Y + (size_t)m * D : nullptr, (bf16_t*)WSP(p, WS_XB) + (size_t)m * D, gp, bp, lane, (const float*)WSP(p, WS_ACUM) + (size_t)(m - TP) * D);
        }
        if (s == 3) break;
        GRID_SYNC();
        if (half) continue;

        {
            CP p = kp(); unsigned char* wl = WSP(p, WS_W + (size_t)l * WL_SIZE);
            pg8::Gemm g{(const bf16_t*)WSP(p, WS_XB), (const bf16_t*)(wl + WL_IN), T, NIN, D}; pg8::StaticOrder S; S.init(T, NIN, D, G, blk);
            EpiZ E{(bf16_t*)WSP(p, WS_HZ)};
            pg8::gemm_phase<EpiZ, pg8::StaticOrder>(lds, g, S, E);
        }
        GRID_SYNC();
#pragma unroll 1
        for (int slot = 0; slot < 4; ++slot) {
            const int cat = (slot + ((blk & 1) << 1)) & 3;
            if (cat == 0) {
                for (int it = blk; it < 256; it += G) { CP p = kp();
                    attn_prompt_item(lds, (const bf16_t*)WSP(p, WS_HZ), (const bf16_t*)WSP(p, WS_KMEM) + (size_t)l * 2048 * 512, (const bf16_t*)WSP(p, WS_VT) + (size_t)l * 512 * 2048,
                                     (bf16_t*)WSP(p, WS_YBR) + 2 * CW, it, tid_()); }
            } else if (cat == 1) {
                for (int it = blk; it < 512; it += G) { CP p = kp();
                    attn_sample_item(lds, (const bf16_t*)WSP(p, WS_HZ), p->in[2] + (size_t)l * 128 * 256 * 512, p->in[3] + (size_t)l * 128 * 256 * 512,
                                     (bf16_t*)WSP(p, WS_YBR) + 2 * CW, it, tid_()); }
            } else if (cat == 2) {
                ZRows zcur;
                { CP p = kp(); zcur = lru_zload((const bf16_t*)WSP(p, WS_HZ), blk < 1056 ? blk : 0, tid_()); }
                for (int it = blk; it < 1056; it += G) { CP p = kp(); unsigned char* wl = WSP(p, WS_W + (size_t)l * WL_SIZE);
                    const ZRows znext = lru_zload((const bf16_t*)WSP(p, WS_HZ), it + G < 1056 ? it + G : it, tid_());
                    lru_item(lds, p, l, (const bf16_t*)WSP(p, WS_HZ), (const bf16_t*)(wl + WL_LWA), (const bf16_t*)(wl + WL_LWX),
                             (float*)WSP(p, WS_ACUM), (float*)WSP(p, WS_BCUM), (float*)WSP(p, WS_AGG), (bf16_t*)WSP(p, WS_YBR) + CW, it, tid_(), zcur, it == blk || (G & 7) != 0);
                    zcur = znext; }
            } else {
                for (int it = (G > 64 ? blk - 32 : blk); it >= 0 && it < 528; it += (G > 64 ? G - 32 : G)) { CP p = kp();
                    conv_item(p, l, (const bf16_t*)WSP(p, WS_HZ), (bf16_t*)WSP(p, WS_YBR), it, tid_()); }
            }
        }
        GRID_SYNC();
#pragma unroll 1
        for (int ph = 0; ph < 2; ++ph) {
            if (ph == 0) {
                for (int it = blk; it < 128; it += G) { CP p = kp();
                    lru_apply_item(p, l, (const bf16_t*)WSP(p, WS_HZ), (const float*)WSP(p, WS_ACUM), (const float*)WSP(p, WS_BCUM), (const float*)WSP(p, WS_AGG),
                                   (bf16_t*)WSP(p, WS_YBR) + CW, it, tid_()); }
            }
            if (ph == 1 && blk >= G - 64) {
                CP p = kp(); const int tid = tid_(), lane = tid & 63, wave = __builtin_amdgcn_readfirstlane(tid >> 6);
                const int m = (blk - (G - 64)) * 8 + wave;
                const float* sb = (const float*)WSP(p, WS_SLB3) + (size_t)m * D; bf16_t* mo = (bf16_t*)WSP(p, WS_MRG) + (size_t)(TP + m) * D;
#pragma unroll
                for (int j = 0; j < 4; ++j) { const f32x4 v = *((const f32x4*)sb + lane + 64 * j) + *((const f32x4*)(sb + (size_t)TS * D) + lane + 64 * j) + *((const f32x4*)(sb + 2 * (size_t)TS * D) + lane + 64 * j);
                    u32x2 w; w.x = cvt_pk_bf16(v[0], v[1]); w.y = cvt_pk_bf16(v[2], v[3]); *((u32x2*)mo + lane + 64 * j) = w; }
            }
            if (ph == 0 && blk >= G - 24) {
                CP p = kp(); unsigned char* wl = WSP(p, WS_W + (size_t)l * WL_SIZE);
                pg8::Gemm g{(const bf16_t*)WSP(p, WS_YBR), (const bf16_t*)(wl + WL_BR), T, D, 3 * CW}; pg8::ChainOrder S; S.init(TP, D, 3 * CW, G, blk, __builtin_amdgcn_readfirstlane(blk - (G - 24)));
                EpiBrS E{(float*)WSP(p, WS_SLB3), (const bf16_t*)WSP(p, WS_HZ) + ZC_GL};
                pg8::gemm_phase<EpiBrS, pg8::ChainOrder>(lds, g, S, E);
            }
            if (ph == 1) {
                CP p = kp(); unsigned char* wl = WSP(p, WS_W + (size_t)l * WL_SIZE);
                pg8::Gemm g{(const bf16_t*)WSP(p, WS_YBR), (const bf16_t*)(wl + WL_BR), T, D, 3 * CW}; pg8::ChainOrder S; S.init(TP, D, 3 * CW, G, blk, -1);
                EpiBr E{(bf16_t*)WSP(p, WS_MRG), (const bf16_t*)WSP(p, WS_HZ) + ZC_GL};
                pg8::gemm_phase<EpiBr, pg8::ChainOrder>(lds, g, S, E);
            }
            GRID_SYNC();
        }
        {
            CP p = kp(); unsigned char* wl = WSP(p, WS_W + (size_t)l * WL_SIZE);
            pg8::Gemm g{(const bf16_t*)WSP(p, WS_MRG), (const bf16_t*)(wl + WL_O), T, D, D}; pg8::TailOrder S; S.init(D, D, G, blk, 4);
            EpiRes<false> E; E.Xout = nullptr; E.slab = (float*)WSP(p, WS_ACUM);
            E.lng = p->in[10] + l * D; E.lnb = p->in[11] + l * D; E.cnt = (unsigned*)p->ws + CW_CNT + (4 + l) * 4096; E.nmini = 32;
            pg8::gemm_phase<EpiRes<false>, pg8::TailOrder>(lds, g, S, E);
        }
        if (blk >= G - 64) {
            CP p = kp(); const int tid = tid_(), lane = tid & 63, wave = __builtin_amdgcn_readfirstlane(tid >> 6);
            unsigned* sc = (unsigned*)p->ws + CW_CNT + (4 + l) * 4096 + 32;
            if (wave == 0) { unsigned sp = 0; while ((unsigned)__builtin_amdgcn_readfirstlane(__hip_atomic_load(sc, __ATOMIC_RELAXED, __HIP_MEMORY_SCOPE_AGENT)) < (unsigned)G) { __builtin_amdgcn_s_sleep(2); if (++sp > (1u << 22)) break; }
                __builtin_amdgcn_fence(__ATOMIC_ACQUIRE, "agent"); asm volatile("s_waitcnt vmcnt(0)" ::: "memory"); }
            __syncthreads();
            const int m = TP + (blk - (G - 64)) * 8 + wave;
            ln_row<4>(nullptr, (bf16_t*)WSP(p, WS_XB) + (size_t)m * D, p->in[10] + l * D, p->in[11] + l * D, lane, (const float*)WSP(p, WS_ACUM) + (size_t)(m - TP) * D);
        }
        GRID_SYNC();
    }
}

extern "C" void kernel_launch(void* const* d_in, const int* in_sizes, int n_in, void* d_out, int out_size, void* d_ws, size_t ws_size, hipStream_t stream) {
    static int grid_blocks = 0;
    if (!grid_blocks) {
        int dev = 0, cus = 0, per_cu = 0;
        (void)hipGetDevice(&dev);
        (void)hipDeviceGetAttribute(&cus, hipDeviceAttributeMultiprocessorCount, dev);
        (void)hipFuncSetAttribute((const void*)mega, hipFuncAttributeMaxDynamicSharedMemorySize, LDS_BYTES);
        (void)hipOccupancyMaxActiveBlocksPerMultiprocessor(&per_cu, (const void*)mega, 512, LDS_BYTES);
        if (per_cu < 1) per_cu = 1;
        grid_blocks = cus * per_cu;
        if (ws_size < WS_END) fprintf(stderr, "kernel_launch: workspace too small: %zu < %zu\n", ws_size, (size_t)WS_END);
    }
    Params p{};
    for (int i = 0; i < 35; ++i) p.in[i] = (const float*)d_in[i];
    p.out = (float*)d_out; p.ws = (unsigned char*)d_ws;
    void* args[] = {&p};
    (void)hipMemsetAsync(d_ws, 0, (size_t)CW_WORDS * 4, stream);
    hipError_t e = hipLaunchCooperativeKernel((const void*)mega, dim3(grid_blocks), dim3(512), args, LDS_BYTES, stream);
    if (e != hipSuccess) fprintf(stderr, "cooperative launch failed: %s (grid %d)\n", hipGetErrorString(e), grid_blocks);
}
```

```cpp
#include <hip/hip_runtime.h>
#include <hip/hip_cooperative_groups.h>
#include <cstdio>
namespace cg = cooperative_groups;

#define LAS __attribute__((address_space(3)))
typedef unsigned short bf16_t;
typedef short bf16x8 __attribute__((ext_vector_type(8)));
typedef float f32x4 __attribute__((ext_vector_type(4)));
typedef unsigned u32x4 __attribute__((ext_vector_type(4)));
typedef unsigned u32x2 __attribute__((ext_vector_type(2)));

constexpr int TP = 16384, TS = 512, T = TP + TS, D = 1024, FF = 2816, NIN = 6144, CW = 512;
constexpr int ZC_CV = 0, ZC_CB = 512, ZC_CC = 1024, ZC_LX = 1536, ZC_LG = 2048, ZC_Q = 2560, ZC_GL = 3072;
constexpr float ALPHA = 1.41421356237309515f, LN_EPS = 1e-5f;
constexpr int LDS_BYTES = 147456;
constexpr size_t O_Y = 0, O_PK = 17301504, O_PV = 19398656, O_PCONV = 21495808, O_PLCONV = 21512192, O_PH = 21536768,
                 O_SCONV = 21544960, O_SLCONV = 21807104, O_SH = 22200320;
constexpr size_t SZ_WGU = (size_t)2 * FF * D * 2, SZ_WD = (size_t)D * FF * 2, SZ_WIN = (size_t)NIN * D * 2, SZ_WBR = (size_t)D * CW * 2,
                 SZ_WO = (size_t)D * D * 2, SZ_LRUW = (size_t)64 * 512 * 2;
constexpr size_t WL_GU1 = 0, WL_D1 = WL_GU1 + SZ_WGU, WL_GU2 = WL_D1 + SZ_WD, WL_D2 = WL_GU2 + SZ_WGU, WL_IN = WL_D2 + SZ_WD,
                 WL_BR = WL_IN + SZ_WIN, WL_O = WL_BR + 3 * SZ_WBR, WL_LWA = WL_O + SZ_WO, WL_LWX = WL_LWA + SZ_LRUW, WL_SIZE = WL_LWX + SZ_LRUW;
constexpr size_t MiB = 1u << 20;
constexpr size_t WS_W = 1 * MiB, WS_WKV = WS_W + 2 * WL_SIZE, WS_MEMB = WS_WKV + 4 * MiB, WS_KMEM = WS_MEMB + 4 * MiB, WS_VT = WS_KMEM + 4 * MiB,
                 WS_XB = WS_VT + 4 * MiB, WS_HZ = WS_XB + (size_t)T * D * 2, WS_YBR = WS_HZ + (size_t)T * NIN * 2,
                 WS_ACUM = WS_YBR + 3 * (size_t)T * CW * 2, WS_BCUM = WS_ACUM + (size_t)T * CW * 4, WS_AGG = WS_BCUM + (size_t)T * CW * 4,
                 WS_MRG = WS_AGG + (size_t)132 * 512 * 2 * 4, WS_END = WS_MRG + (size_t)T * D * 2;
static_assert(WS_END < 565ull * 1000 * 1000, "workspace budget");
constexpr size_t WS_SLB3 = WS_ACUM + (size_t)T * CW * 2;
static_assert(WS_SLB3 + 3 * (size_t)TS * D * 4 <= WS_BCUM, "sample branch slabs fit behind the bf16 cumulants");

constexpr int CW_CNT = 4096, CW_WORDS = 4096 + 6 * 64 * 64;
constexpr size_t WS_XCH = 512 * 1024;
struct Params { const float* in[35]; float* out; unsigned char* ws; };
typedef const __attribute__((address_space(4))) Params* CP;
__device__ __forceinline__ CP kp() { CP q = (CP)__builtin_amdgcn_kernarg_segment_ptr(); asm volatile("" : "+s"(q)); return q; }
__device__ __forceinline__ int tid_() { int t = threadIdx.x; asm volatile("" : "+v"(t)); return t; }

__device__ __forceinline__ unsigned cvt_pk_bf16(float lo, float hi) { unsigned r; asm("v_cvt_pk_bf16_f32 %0, %1, %2" : "=v"(r) : "v"(lo), "v"(hi)); return r; }
__device__ __forceinline__ float bf_lo(unsigned u) { return __uint_as_float(u << 16); }
__device__ __forceinline__ float bf_hi(unsigned u) { return __uint_as_float(u & 0xffff0000u); }
__device__ __forceinline__ float bf2f(bf16_t b) { return __uint_as_float(((unsigned)b) << 16); }
__device__ __forceinline__ float sigmoidf_(float x) { return __builtin_amdgcn_rcpf(1.0f + __expf(-x)); }
__device__ __forceinline__ float silu_(float x) { return x * sigmoidf_(x); }
__device__ __forceinline__ float one_minus_exp_(float x) {
    const float ser = -x * (1.0f + x * (0.5f + x * (0.16666667f + x * (0.041666668f + x * (0.0083333338f + x * 0.0013888889f)))));
    return x > -0.25f ? ser : 1.0f - __expf(x);
}
__device__ __forceinline__ float softplus_neg_(float lam) {
    const float y = __expf(-lam);
    const float ser = y * (1.0f - y * (0.5f - y * (0.33333334f - y * 0.25f)));
    return y < 0.03f ? ser : __logf(1.0f + y);
}
__device__ __forceinline__ float gelu_tanh_(float x) { return x * sigmoidf_(1.5957691216057308f * (x + 0.044715f * x * x * x)); }
__device__ __forceinline__ float wave_sum(float v) {
#pragma unroll
    for (int o = 1; o < 64; o <<= 1) v += __shfl_xor(v, o);
    return v;
}
__device__ __forceinline__ float wave_max(float v) {
#pragma unroll
    for (int o = 1; o < 64; o <<= 1) v = fmaxf(v, __shfl_xor(v, o));
    return v;
}
__device__ __forceinline__ void unpack8(const u32x4 v, float (&f)[8]) {
    f[0] = bf_lo(v.x); f[1] = bf_hi(v.x); f[2] = bf_lo(v.y); f[3] = bf_hi(v.y); f[4] = bf_lo(v.z); f[5] = bf_hi(v.z); f[6] = bf_lo(v.w); f[7] = bf_hi(v.w);
}

namespace pg8 {
constexpr int BM = 256, BK = 64, HALF = 128, HTB = HALF * BK * 2, STAGE_BYTES = 8 * HTB, NXCD = 8, WGM = 8;
__device__ __forceinline__ int lds_byte(int r, int c) { const int st = (r >> 4) * 2 + (c >> 5), rr = r & 15, cc = c & 31, ob = rr * 64 + cc * 2; return st * 1024 + (ob ^ (((ob >> 9) & 1) << 5)); }
__device__ __forceinline__ void stage_rc(int b, int& R, int& C) { const int st = b / 1024, sb = b % 1024, swz = sb ^ (((sb >> 9) & 1) << 5); R = (st >> 1) * 16 + swz / 64; C = (st & 1) * 32 + (swz % 64) / 2; }
__device__ __forceinline__ int perm32(int rho) { const int n = rho >> 4, i = rho & 15; return 8 * (i >> 2) + 4 * n + (i & 3); }
struct Unit { int pm, pn, k0, nkt; };
struct Gemm { const bf16_t* A; const bf16_t* Bt; int M, N, K; };
struct StaticOrder {
    int nM, nN, nwg, G, c, kt;
    __device__ __forceinline__ void init(int M, int N, int K, int G_, int c_) { nM = M / BM; nN = N / BM; nwg = nM * nN; G = G_; c = c_; kt = K / BK; }
    __device__ __forceinline__ bool next(int i, int& pm, int& pn, int& k0, int& nkt) const {
        const int L = i * G + c; k0 = 0; nkt = kt; pm = 0; pn = 0;
        if (L >= nwg) return false;
        int wgid = L; { const int q = nwg / NXCD, r = nwg % NXCD, xcd = wgid % NXCD, off = wgid / NXCD; wgid = (xcd < r ? xcd * (q + 1) : r * (q + 1) + (xcd - r) * q) + off; }
        const int nig = WGM * nN, gid = wgid / nig, fm = gid * WGM, gsz = (nM - fm) < WGM ? (nM - fm) : WGM;
        pm = fm + ((wgid % nig) % gsz); pn = (wgid % nig) / gsz; return true;
    }
};

struct TailOrder {
    StaticOrder P; int nsplit, ktm, nmini;
    __device__ __forceinline__ void init(int N, int K, int G_, int c_, int nsplit_) { P.init(16384, N, K, G_, c_); nsplit = nsplit_; ktm = (K / BK) / nsplit_; nmini = 2 * P.nN * nsplit_; }
    __device__ __forceinline__ bool next(int i, int& pm, int& pn, int& k0, int& nkt) const {
        const bool has_mini = P.c < nmini;
        if (has_mini && i == 0) { const int j = P.c, tile = j / nsplit, sp = j - tile * nsplit;
            pm = 64 + tile / P.nN; pn = tile % P.nN; k0 = sp * ktm; nkt = ktm; return true; }
        const int ip = has_mini ? i - 1 : i;
        const bool ok = P.next(0, pm, pn, k0, nkt);
        return ok && ip == 0;
    }
};

struct ChainOrder {
    StaticOrder P; int segk, sc;
    __device__ __forceinline__ void init(int M, int N, int K, int G_, int c_, int sc_) { P.init(M, N, K, G_, c_); segk = (K / BK) / 3; sc = sc_; }
    __device__ __forceinline__ bool next(int i, int& pm, int& pn, int& k0, int& nkt) const {
        const int r = i / 3, sg = i - 3 * r; int d0, d1;
        bool ok = P.next(r, pm, pn, d0, d1);
        k0 = sg * segk; nkt = segk;
        if (sc >= 0) { const int tile = sc / 3; pm = 64 + (tile >> 2); pn = tile & 3; k0 = (sc - 3 * tile) * segk; ok = (i == 0); }
        return ok;
    }
};

template <class Epi, class Sched>
__device__ __forceinline__ void gemm_phase(LAS unsigned char* lds, const Gemm g, const Sched& S, const Epi& E) {
    const int tid = tid_(), wid = __builtin_amdgcn_readfirstlane(tid >> 6), lane = tid & 63, wr = wid >> 2, wc = wid & 3, fr = lane & 15, fq = lane >> 4;
    const int K = g.K;
    unsigned voffA[2], voffB[2];
#pragma unroll
    for (int i = 0; i < 2; ++i) { int R, C; stage_rc(tid * 16 + i * 8192, R, C); const int Rb = Epi::PERM ? ((R & ~31) + perm32(R & 31)) : R;
        voffA[i] = (unsigned)(R * K + C) * 2u; voffB[i] = (unsigned)(Rb * K + C) * 2u; }
    const size_t kstep = (size_t)(BK * 2);
    const size_t hstep = (size_t)HALF * K * 2;
    const size_t tstep = 2 * hstep;
    const unsigned ldsw = (unsigned)wid * 1024u;
    const int aoff = lds_byte(wr * 64 + fr, fq * 8), boff = lds_byte(wc * 32 + fr, fq * 8);
#define PG8_SA(b, h) (((b) * 2 + (h)) * HTB)
#define PG8_SB(b, h) ((4 + (b) * 2 + (h)) * HTB)
#define PG8_STAGE(bufoff, gbase, voff) do { _Pragma("unroll") for (int _i = 0; _i < 2; ++_i) \
        __builtin_amdgcn_global_load_lds((const unsigned*)((const char*)(gbase) + (voff)[_i]), (LAS unsigned*)(lds + (bufoff) + ldsw + _i * 8192), 16, 0, 0); } while (0)
#define PG8_LDA(dst, b, h) do { _Pragma("unroll") for (int m = 0; m < 4; ++m) _Pragma("unroll") for (int k = 0; k < 2; ++k) dst[m][k] = *(const LAS bf16x8*)(lds + PG8_SA(b, h) + aoff + m * 2048 + k * 1024); } while (0)
#define PG8_LDB(dst, b, h) do { _Pragma("unroll") for (int n = 0; n < 2; ++n) _Pragma("unroll") for (int k = 0; k < 2; ++k) dst[n][k] = *(const LAS bf16x8*)(lds + PG8_SB(b, h) + boff + n * 2048 + k * 1024); } while (0)
#define PG8_MMA(ai, bj, At, Bt) do { __builtin_amdgcn_s_setprio(1); _Pragma("unroll") for (int m = 0; m < 4; ++m) _Pragma("unroll") for (int n = 0; n < 2; ++n) _Pragma("unroll") for (int k = 0; k < 2; ++k) \
        acc[ai][bj][m][n] = __builtin_amdgcn_mfma_f32_16x16x32_bf16(Bt[n][k], At[m][k], acc[ai][bj][m][n], 0, 0, 0); __builtin_amdgcn_s_setprio(0); } while (0)
#define PG8_WAIT_V(n) asm volatile("s_waitcnt vmcnt(" #n ")" ::: "memory")
#define PG8_WAIT_L(n) asm volatile("s_waitcnt lgkmcnt(" #n ")" ::: "memory")
#define PG8_BAR __builtin_amdgcn_s_barrier()
#define PG8_SCHED __builtin_amdgcn_sched_barrier(0)
    int cpm, cpn, ck0, cnk, npm, npn, nk0, nnk; int ui = 0;
    if (!S.next(0, cpm, cpn, ck0, cnk)) return;
    f32x4 acc[2][2][4][2];
#pragma unroll
    for (int a = 0; a < 2; ++a)
#pragma unroll
        for (int b = 0; b < 2; ++b)
#pragma unroll
            for (int m = 0; m < 4; ++m)
#pragma unroll
                for (int n = 0; n < 2; ++n) acc[a][b][m][n] = (f32x4){0.f, 0.f, 0.f, 0.f};
    bf16x8 At[4][2], B0[2][2], B1[2][2];
    const char* cA = (const char*)g.A + (size_t)cpm * tstep + (size_t)ck0 * kstep; const char* cB = (const char*)g.Bt + (size_t)cpn * tstep + (size_t)ck0 * kstep;
    PG8_STAGE(PG8_SB(0, 0), cB, voffB); PG8_STAGE(PG8_SA(0, 0), cA, voffA); PG8_STAGE(PG8_SB(0, 1), cB + hstep, voffB); PG8_STAGE(PG8_SA(0, 1), cA + hstep, voffA);
    if (wr == 1) PG8_BAR;
    PG8_WAIT_V(4); PG8_BAR;
    PG8_STAGE(PG8_SB(1, 0), cB + kstep, voffB); PG8_STAGE(PG8_SA(1, 0), cA + kstep, voffA); PG8_STAGE(PG8_SB(1, 1), cB + hstep + kstep, voffB);
    PG8_WAIT_V(6); PG8_BAR;
    for (;;) {
        const bool has_next = S.next(ui + 1, npm, npn, nk0, nnk);
        const char* nA = has_next ? (const char*)g.A + (size_t)npm * tstep + (size_t)nk0 * kstep : cA; const char* nB = has_next ? (const char*)g.Bt + (size_t)npn * tstep + (size_t)nk0 * kstep : cB;
        const int nt = cnk;
        for (int t = 0; t < nt; t += 2) {
            const bool last = (t == nt - 2);
            const char* a1 = cA + (size_t)(t + 1) * kstep;
            const char* a2 = last ? nA : cA + (size_t)(t + 2) * kstep; const char* b2 = last ? nB : cB + (size_t)(t + 2) * kstep;
            const char* a3 = a2 + kstep; const char* b3 = b2 + kstep;
            PG8_LDB(B0, 0, 0); PG8_SCHED; PG8_LDA(At, 0, 0); PG8_STAGE(PG8_SA(1, 1), a1 + hstep, voffA);
            PG8_WAIT_L(8); PG8_BAR; PG8_WAIT_L(0); PG8_MMA(0, 0, At, B0); PG8_BAR; PG8_SCHED;
            PG8_LDB(B1, 0, 1); PG8_STAGE(PG8_SB(0, 0), b2, voffB);
            PG8_BAR; PG8_WAIT_L(0); PG8_MMA(0, 1, At, B1); PG8_BAR;
            PG8_LDA(At, 0, 1); PG8_STAGE(PG8_SA(0, 0), a2, voffA);
            PG8_BAR; PG8_WAIT_L(0); PG8_MMA(1, 0, At, B0); PG8_BAR; PG8_SCHED;
            PG8_STAGE(PG8_SB(0, 1), b2 + hstep, voffB);
            PG8_WAIT_V(6); PG8_BAR; PG8_MMA(1, 1, At, B1); PG8_BAR;
            PG8_LDB(B0, 1, 0); PG8_SCHED; PG8_LDA(At, 1, 0); PG8_STAGE(PG8_SA(0, 1), a2 + hstep, voffA);
            PG8_WAIT_L(8); PG8_BAR; PG8_WAIT_L(0); PG8_MMA(0, 0, At, B0); PG8_BAR; PG8_SCHED;
            PG8_LDB(B1, 1, 1); PG8_STAGE(PG8_SB(1, 0), b3, voffB);
            PG8_BAR; PG8_WAIT_L(0); PG8_MMA(0, 1, At, B1); PG8_BAR;
            PG8_LDA(At, 1, 1); PG8_STAGE(PG8_SA(1, 0), a3, voffA);
            PG8_BAR; PG8_WAIT_L(0); PG8_MMA(1, 0, At, B0); PG8_BAR; PG8_SCHED;
            PG8_STAGE(PG8_SB(1, 1), b3 + hstep, voffB);
            PG8_WAIT_V(6); PG8_BAR; PG8_MMA(1, 1, At, B1); PG8_BAR;
        }
        if (has_next || !Epi::AFTER_DRAIN) { Unit cu; cu.pm = cpm; cu.pn = cpn; cu.k0 = ck0; cu.nkt = cnk; E(acc, cu, wr, wc, fr, fq); }
        if (!has_next) break;
        if (!(Epi::CHAIN && nk0 != 0)) {
#pragma unroll
        for (int a = 0; a < 2; ++a)
#pragma unroll
            for (int b = 0; b < 2; ++b)
#pragma unroll
                for (int m = 0; m < 4; ++m)
#pragma unroll
                    for (int n = 0; n < 2; ++n) acc[a][b][m][n] = (f32x4){0.f, 0.f, 0.f, 0.f};
        }
        cpm = npm; cpn = npn; ck0 = nk0; cnk = nnk; cA = nA; cB = nB; ++ui;
    }
    PG8_WAIT_V(0);
    if (wr == 0) PG8_BAR;
    PG8_BAR;
    if constexpr (Epi::AFTER_DRAIN) E.fused(acc, cpm, cpn, wr, wc, fr, fq, lds, wid, lane);
#undef PG8_SA
#undef PG8_SB
#undef PG8_STAGE
#undef PG8_LDA
#undef PG8_LDB
#undef PG8_MMA
#undef PG8_WAIT_V
#undef PG8_WAIT_L
#undef PG8_BAR
#undef PG8_SCHED
}
}
using pg8::Unit;
typedef f32x4 AccT[2][2][4][2];

struct EpiGU {
    static constexpr bool AFTER_DRAIN = false, CHAIN = false, PERM = true;
    bf16_t* H;
    __device__ __forceinline__ void operator()(AccT& acc, const Unit& u, int wr, int wc, int fr, int fq) const {
        const int row0 = u.pm * 256 + wr * 64 + fr, col0 = u.pn * 128 + wc * 32 + 8 * fq;
#pragma unroll
        for (int ai = 0; ai < 2; ++ai)
#pragma unroll
            for (int m = 0; m < 4; ++m) {
                bf16_t* rowp = H + (size_t)(row0 + ai * 128 + m * 16) * FF + col0;
                const f32x4 g0 = acc[ai][0][m][0], g1 = acc[ai][0][m][1], u0 = acc[ai][1][m][0], u1 = acc[ai][1][m][1];
                u32x4 w;
                w.x = cvt_pk_bf16(silu_(g0[0]) * u0[0], silu_(g0[1]) * u0[1]); w.y = cvt_pk_bf16(silu_(g0[2]) * u0[2], silu_(g0[3]) * u0[3]);
                w.z = cvt_pk_bf16(silu_(g1[0]) * u1[0], silu_(g1[1]) * u1[1]); w.w = cvt_pk_bf16(silu_(g1[2]) * u1[2], silu_(g1[3]) * u1[3]);
                *(u32x4*)rowp = w;
            }
    }
};
__device__ __forceinline__ void panel_stats_run(unsigned* xbuf, unsigned* cnt, const AccT& v, const int upm, const int upn, int wr, int wc, int fr, int fq, LAS unsigned char* lds, int wid, int lane) {
    {
        typedef float f32x2v __attribute__((ext_vector_type(2)));
        LAS f32x2v* Pt = (LAS f32x2v*)lds;
        LAS f32x2v* St = (LAS f32x2v*)(lds + 8192);
#pragma unroll
        for (int ai = 0; ai < 2; ++ai)
#pragma unroll
            for (int m = 0; m < 4; ++m) {
                float s = 0.f;
#pragma unroll
                for (int bj = 0; bj < 2; ++bj)
#pragma unroll
                    for (int n = 0; n < 2; ++n) { const f32x4 x = v[ai][bj][m][n]; s += (x[0] + x[1]) + (x[2] + x[3]); }
                s += __shfl_xor(s, 16); s += __shfl_xor(s, 32);
                const float mw = s * (1.0f / 64.0f); float q = 0.f;
#pragma unroll
                for (int bj = 0; bj < 2; ++bj)
#pragma unroll
                    for (int n = 0; n < 2; ++n) { const f32x4 d = v[ai][bj][m][n] - mw; q += (d[0] * d[0] + d[1] * d[1]) + (d[2] * d[2] + d[3] * d[3]); }
                q += __shfl_xor(q, 16); q += __shfl_xor(q, 32);
                if (fq == 0) Pt[(ai * 128 + wr * 64 + m * 16 + fr) * 4 + wc] = (f32x2v){mw, q};
                __builtin_amdgcn_sched_barrier(0);
            }
        asm volatile("s_waitcnt lgkmcnt(0)" ::: "memory"); __builtin_amdgcn_s_barrier(); asm volatile("" ::: "memory");
        const int row = wid * 32 + (lane & 31);
        if (lane < 32) {
            const f32x2v a = Pt[row * 4 + 0], b = Pt[row * 4 + 1], c = Pt[row * 4 + 2], d = Pt[row * 4 + 3];
            const float mt = (a.x + b.x + c.x + d.x) * 0.25f;
            const float da = a.x - mt, db = b.x - mt, dc = c.x - mt, dd = d.x - mt;
            const float m2 = (a.y + b.y) + (c.y + d.y) + 64.0f * ((da * da + db * db) + (dc * dc + dd * dd));
            unsigned long long* slot = (unsigned long long*)xbuf + ((size_t)(upm * 256 + row) * 4 + upn);
            __hip_atomic_store(slot, ((unsigned long long)__float_as_uint(m2) << 32) | __float_as_uint(mt), __ATOMIC_RELAXED, __HIP_MEMORY_SCOPE_AGENT);
        }
        asm volatile("s_waitcnt vmcnt(0)" ::: "memory");
        if (lane == 0) __hip_atomic_fetch_add(cnt + 64 * upm, 1u, __ATOMIC_RELAXED, __HIP_MEMORY_SCOPE_AGENT);
        if (wid == 0) {
            unsigned sp = 0;
            while ((unsigned)__builtin_amdgcn_readfirstlane(__hip_atomic_load(cnt + 64 * upm, __ATOMIC_RELAXED, __HIP_MEMORY_SCOPE_AGENT)) < 32u) {
                __builtin_amdgcn_s_sleep(1); if (++sp > (1u << 22)) break; }
            __builtin_amdgcn_fence(__ATOMIC_ACQUIRE, "agent");
        }
        asm volatile("s_waitcnt vmcnt(0) lgkmcnt(0)" ::: "memory"); __builtin_amdgcn_s_barrier(); asm volatile("" ::: "memory");
        if (lane < 32) {
            const unsigned long long* slot = (const unsigned long long*)xbuf + (size_t)(upm * 256 + row) * 4; float mt[4], m2[4]; float ms = 0.f;
#pragma unroll
            for (int t = 0; t < 4; ++t) { const unsigned long long w = __hip_atomic_load(slot + t, __ATOMIC_RELAXED, __HIP_MEMORY_SCOPE_AGENT); mt[t] = __uint_as_float((unsigned)w); m2[t] = __uint_as_float((unsigned)(w >> 32)); ms += mt[t]; }
            const float mean = ms * 0.25f; float q = 0.f;
#pragma unroll
            for (int t = 0; t < 4; ++t) { const float dm = mt[t] - mean; q += m2[t] + 256.0f * dm * dm; }
            St[row] = (f32x2v){mean, 1.0f / sqrtf(q * (1.0f / 1024.0f) + LN_EPS)};
        }
        asm volatile("s_waitcnt lgkmcnt(0)" ::: "memory"); __builtin_amdgcn_s_barrier(); asm volatile("" ::: "memory");
    }
}
template <bool HALF> struct EpiRes {
    static constexpr bool CHAIN = false, PERM = true, AFTER_DRAIN = true;
    static constexpr float scale = HALF ? 0.5f : 1.0f;
    float* Xout; float* slab; const float* lng; const float* lnb; unsigned* cnt; int nmini;
    __device__ __forceinline__ void operator()(AccT& acc, const Unit& u, int wr, int wc, int fr, int fq) const {
        const int row0 = u.pm * 256 + wr * 64 + fr, col0 = u.pn * 256 + wc * 32 + 8 * fq;
        const int sp = u.k0 / u.nkt;
        float* base = slab + ((size_t)sp * TS + (row0 - TP)) * D + col0;
#pragma unroll
        for (int ai = 0; ai < 2; ++ai)
#pragma unroll
            for (int m = 0; m < 4; ++m)
#pragma unroll
                for (int bj = 0; bj < 2; ++bj) { float* pp = base + (size_t)(ai * 128 + m * 16) * D + bj * 128;
                    *(f32x4*)pp = acc[ai][bj][m][0] * scale; *(f32x4*)(pp + 4) = acc[ai][bj][m][1] * scale; }
    }
    __device__ __forceinline__ void fused(AccT& acc, const int upm, const int upn, int, int, int, int, LAS unsigned char* lds, int, int) const {
        typedef float f32x2v __attribute__((ext_vector_type(2)));
        const int tid2 = tid_(), wid = __builtin_amdgcn_readfirstlane(tid2 >> 6), lane = tid2 & 63, wr = wid >> 2, wc = wid & 3, fr = lane & 15, fq = lane >> 4;
        const int row0 = upm * 256 + wr * 64 + fr, col0 = upn * 256 + wc * 32 + 8 * fq;
        bf16_t* XB = (bf16_t*)((unsigned char*)slab - (WS_ACUM - WS_XB)); unsigned* xbuf = (unsigned*)((unsigned char*)slab - (WS_ACUM - WS_XCH));
        bf16_t* bb = XB + (size_t)row0 * D + col0;
        if (wid == 0) {
            if ((int)blockIdx.x < nmini) { __builtin_amdgcn_fence(__ATOMIC_RELEASE, "agent"); asm volatile("s_waitcnt vmcnt(0)" ::: "memory"); }
            if (lane == 0) __hip_atomic_fetch_add(cnt + 32, 1u, __ATOMIC_RELAXED, __HIP_MEMORY_SCOPE_AGENT);
        }
        {
            u32x4 v[2][4][2];
#pragma unroll
            for (int ai = 0; ai < 2; ++ai)
#pragma unroll
                for (int m = 0; m < 4; ++m)
#pragma unroll
                    for (int bj = 0; bj < 2; ++bj) v[ai][m][bj] = *(const u32x4*)(bb + (size_t)(ai * 128 + m * 16) * D + bj * 128);
#pragma unroll
            for (int ai = 0; ai < 2; ++ai) {
#pragma unroll
                for (int m = 0; m < 4; ++m)
#pragma unroll
                    for (int bj = 0; bj < 2; ++bj) { float x[8]; unpack8(v[ai][m][bj], x);
                        acc[ai][bj][m][0] = (f32x4){x[0], x[1], x[2], x[3]} * ALPHA + acc[ai][bj][m][0] * scale;
                        acc[ai][bj][m][1] = (f32x4){x[4], x[5], x[6], x[7]} * ALPHA + acc[ai][bj][m][1] * scale; }
#pragma unroll
                for (int m = 0; m < 4; ++m) asm volatile("" : "+v"(acc[ai][0][m][0]), "+v"(acc[ai][0][m][1]), "+v"(acc[ai][1][m][0]), "+v"(acc[ai][1][m][1]));
            }
            asm volatile("" ::: "memory");
        }
        panel_stats_run(xbuf, cnt, acc, upm, upn, wr, wc, fr, fq, lds, wid, lane);
        asm volatile("" ::: "memory");
        const LAS f32x2v* St = (const LAS f32x2v*)(lds + 8192);
        float* xo = Xout ? Xout + (size_t)row0 * D + col0 : nullptr;
        f32x4 gq[2][2], bq[2][2];
#pragma unroll
        for (int bj = 0; bj < 2; ++bj) { gq[bj][0] = *(const f32x4*)(lng + col0 + bj * 128); gq[bj][1] = *(const f32x4*)(lng + col0 + bj * 128 + 4);
            bq[bj][0] = *(const f32x4*)(lnb + col0 + bj * 128); bq[bj][1] = *(const f32x4*)(lnb + col0 + bj * 128 + 4); }
#pragma unroll
        for (int ai = 0; ai < 2; ++ai)
#pragma unroll
            for (int m = 0; m < 4; ++m) { const f32x2v sr = St[ai * 128 + wr * 64 + m * 16 + fr];
#pragma unroll
                for (int bj = 0; bj < 2; ++bj) { const size_t off = (size_t)(ai * 128 + m * 16) * D + bj * 128;
                    const f32x4 g0 = gq[bj][0], g1 = gq[bj][1], b0 = bq[bj][0], b1 = bq[bj][1];
                    const f32x4 y0 = (acc[ai][bj][m][0] - sr.x) * sr.y * g0 + b0, y1 = (acc[ai][bj][m][1] - sr.x) * sr.y * g1 + b1;
                    if (xo) { *(f32x4*)(xo + off) = y0; *(f32x4*)(xo + off + 4) = y1; }
                    u32x4 w; w.x = cvt_pk_bf16(y0[0], y0[1]); w.y = cvt_pk_bf16(y0[2], y0[3]); w.z = cvt_pk_bf16(y1[0], y1[1]); w.w = cvt_pk_bf16(y1[2], y1[3]); *(u32x4*)(bb + off) = w; }
                asm volatile("" ::: "memory"); }
    }
};
struct EpiZ {
    static constexpr bool AFTER_DRAIN = false, CHAIN = false, PERM = true;
    bf16_t* Z;
    __device__ __forceinline__ void operator()(AccT& acc, const Unit& u, int wr, int wc, int fr, int fq) const {
        const int row0 = u.pm * 256 + wr * 64 + fr, col0 = u.pn * 256 + wc * 32 + 8 * fq;
        const int mode = (u.pn >= 12) ? 2 : ((u.pn == 8 || u.pn == 9) ? 1 : 0);
#pragma unroll
        for (int ai = 0; ai < 2; ++ai)
#pragma unroll
            for (int m = 0; m < 4; ++m) {
                bf16_t* rowp = Z + (size_t)(row0 + ai * 128 + m * 16) * NIN + col0;
#pragma unroll
                for (int bj = 0; bj < 2; ++bj) {
                    f32x4 v0 = acc[ai][bj][m][0], v1 = acc[ai][bj][m][1];
                    if (mode == 2) {
#pragma unroll
                        for (int j = 0; j < 4; ++j) { v0[j] = sigmoidf_(v0[j]); v1[j] = sigmoidf_(v1[j]); }
                    } else if (mode == 1) {
#pragma unroll
                        for (int j = 0; j < 4; ++j) { v0[j] = gelu_tanh_(v0[j]); v1[j] = gelu_tanh_(v1[j]); }
                    }
                    u32x4 w; w.x = cvt_pk_bf16(v0[0], v0[1]); w.y = cvt_pk_bf16(v0[2], v0[3]); w.z = cvt_pk_bf16(v1[0], v1[1]); w.w = cvt_pk_bf16(v1[2], v1[3]);
                    *(u32x4*)(rowp + bj * 128) = w;
                }
            }
    }
};
struct EpiKV {
    static constexpr bool AFTER_DRAIN = false, CHAIN = false, PERM = false;
    float* out; bf16_t* KM; bf16_t* VT;
    __device__ __forceinline__ void operator()(AccT& acc, const Unit& u, int wr, int wc, int fr, int fq) const {
        const int l = u.pn >> 2, kv = (u.pn >> 1) & 1, half = u.pn & 1;
        float* ob = out + (kv ? O_PV : O_PK) + (size_t)l * 2048 * 512;
#pragma unroll
        for (int ai = 0; ai < 2; ++ai)
#pragma unroll
            for (int m = 0; m < 4; ++m) {
                const int r = u.pm * 256 + ai * 128 + wr * 64 + m * 16 + fr;
                const int k32 = r & 31, kc = k32 >> 2, pc = (kc < 4) ? 2 * kc : 2 * (kc - 4) + 1, pos = (r & ~31) + pc * 4 + (k32 & 3);
#pragma unroll
                for (int bj = 0; bj < 2; ++bj)
#pragma unroll
                    for (int n = 0; n < 2; ++n) {
                        const int cc = half * 256 + bj * 128 + wc * 32 + n * 16 + 4 * fq;
                        const f32x4 v = acc[ai][bj][m][n];
                        *(f32x4*)(ob + (size_t)r * 512 + cc) = v;
                        if (!kv) { u32x2 w; w.x = cvt_pk_bf16(v[0], v[1]); w.y = cvt_pk_bf16(v[2], v[3]); *(u32x2*)(KM + ((size_t)l * 2048 + r) * 512 + cc) = w; }
                        else {
                            const unsigned w0 = cvt_pk_bf16(v[0], v[1]), w1 = cvt_pk_bf16(v[2], v[3]);
                            bf16_t* vt = VT + ((size_t)l * 512 + cc) * 2048 + pos;
                            vt[0] = (bf16_t)(w0 & 0xffffu); vt[2048] = (bf16_t)(w0 >> 16); vt[4096] = (bf16_t)(w1 & 0xffffu); vt[6144] = (bf16_t)(w1 >> 16);
                        }
                    }
            }
    }
};
struct EpiBrS {
    static constexpr bool AFTER_DRAIN = false, CHAIN = false, PERM = true;
    float* slab3; const bf16_t* gate;
    __device__ __forceinline__ void operator()(AccT& acc, const Unit& u, int wr, int wc, int fr, int fq) const {
        const int sg = u.k0 / u.nkt;
        const int row0 = u.pm * 256 + wr * 64 + fr, col0 = u.pn * 256 + wc * 32 + 8 * fq;
        const bf16_t* gb = gate + (size_t)row0 * NIN + col0 + sg * D;
        float* sb = slab3 + ((size_t)sg * TS + (row0 - TP)) * D + col0;
#pragma unroll
        for (int ai = 0; ai < 2; ++ai)
#pragma unroll
            for (int m = 0; m < 4; ++m) {
                u32x4 gs[2];
#pragma unroll
                for (int bj = 0; bj < 2; ++bj) gs[bj] = *(const u32x4*)(gb + (size_t)(ai * 128 + m * 16) * NIN + bj * 128);
#pragma unroll
                for (int bj = 0; bj < 2; ++bj) { float nn[8]; unpack8(gs[bj], nn); float* pp = sb + (size_t)(ai * 128 + m * 16) * D + bj * 128;
                    f32x4 v0 = acc[ai][bj][m][0], v1 = acc[ai][bj][m][1];
                    v0[0] *= nn[0]; v0[1] *= nn[1]; v0[2] *= nn[2]; v0[3] *= nn[3]; v1[0] *= nn[4]; v1[1] *= nn[5]; v1[2] *= nn[6]; v1[3] *= nn[7];
                    *(f32x4*)pp = v0; *(f32x4*)(pp + 4) = v1; }
                asm volatile("" ::: "memory");
            }
    }
};
struct EpiBr {
    static constexpr bool AFTER_DRAIN = false, CHAIN = true, PERM = true;
    bf16_t* mrg; const bf16_t* gate;
    __device__ __forceinline__ void operator()(AccT& acc, const Unit& u, int wr, int wc, int fr, int fq) const {
        const int sg = u.k0 / u.nkt;
        const int row0 = u.pm * 256 + wr * 64 + fr, col0 = u.pn * 256 + wc * 32 + 8 * fq;
        const bf16_t* gb = gate + (size_t)row0 * NIN + col0 + sg * D; bf16_t* mb = mrg + (size_t)row0 * D + col0;
#pragma unroll
        for (int ai = 0; ai < 2; ++ai) {
            u32x4 gn[4][2], gd[4][2];
#pragma unroll
            for (int m = 0; m < 4; ++m)
#pragma unroll
                for (int bj = 0; bj < 2; ++bj) { const size_t ro = (size_t)(ai * 128 + m * 16); const int co = bj * 128;
                    gn[m][bj] = *(const u32x4*)(gb + ro * NIN + co);
                    if (sg < 2) gd[m][bj] = *(const u32x4*)(gb + ro * NIN + co + D); else gd[m][bj] = gn[m][bj]; }
#pragma unroll
            for (int m = 0; m < 4; ++m)
#pragma unroll
                for (int bj = 0; bj < 2; ++bj) { const size_t ro = (size_t)(ai * 128 + m * 16); const int co = bj * 128;
                    float nn[8], dd[8]; unpack8(gn[m][bj], nn); unpack8(gd[m][bj], dd);
#pragma unroll
                    for (int e = 0; e < 8; ++e) { nn[e] = fmaxf(nn[e], 1e-30f); if (sg < 2) nn[e] *= __builtin_amdgcn_rcpf(fmaxf(dd[e], 1e-30f)); }
                    f32x4 v0 = acc[ai][bj][m][0], v1 = acc[ai][bj][m][1];
                    v0[0] *= nn[0]; v0[1] *= nn[1]; v0[2] *= nn[2]; v0[3] *= nn[3]; v1[0] *= nn[4]; v1[1] *= nn[5]; v1[2] *= nn[6]; v1[3] *= nn[7];
                    if (sg < 2) { acc[ai][bj][m][0] = v0; acc[ai][bj][m][1] = v1; }
                    else { u32x4 w; w.x = cvt_pk_bf16(v0[0], v0[1]); w.y = cvt_pk_bf16(v0[2], v0[3]); w.z = cvt_pk_bf16(v1[0], v1[1]); w.w = cvt_pk_bf16(v1[2], v1[3]); *(u32x4*)(mb + ro * D + co) = w; } }
        }
    }
};

__device__ __forceinline__ void transpose_item(const float* W, int N, bf16_t* WT, int ldd, int row_off, int mode, LAS float* scr, int item, int lane) {
    const int nblk = N / 32, kb = item / nblk, nb = item % nblk, k0 = 64 * kb, n0 = 32 * nb;
    const int drow0 = (mode == 0) ? (row_off + n0) : (((n0 >> 7) << 8) + (n0 & 127) + (mode == 2 ? 128 : 0));
    float wv[32];
#pragma unroll
    for (int i = 0; i < 32; ++i) { const int kk = 2 * i + (lane >> 5); wv[i] = __builtin_nontemporal_load(W + (size_t)(k0 + kk) * N + n0 + (lane & 31)); }
#pragma unroll
    for (int i = 0; i < 32; ++i) { const int kk = 2 * i + (lane >> 5); scr[kk * 33 + (lane & 31)] = wv[i]; }
    asm volatile("s_waitcnt lgkmcnt(0)" ::: "memory");
    const int c = lane & 7;
#pragma unroll
    for (int j = 0; j < 4; ++j) { const int n = (lane >> 3) + 8 * j; const LAS float* s = scr + (8 * c) * 33 + n;
        u32x4 o; o.x = cvt_pk_bf16(s[0 * 33], s[1 * 33]); o.y = cvt_pk_bf16(s[2 * 33], s[3 * 33]); o.z = cvt_pk_bf16(s[4 * 33], s[5 * 33]); o.w = cvt_pk_bf16(s[6 * 33], s[7 * 33]);
        *(u32x4*)(WT + (size_t)(drow0 + n) * ldd + k0 + 8 * c) = o; }
    asm volatile("s_waitcnt lgkmcnt(0)" ::: "memory");
}

__device__ __forceinline__ void row_cvt(const float* src, float* dstf, bf16_t* dstb, int lane, float fscale) {
#pragma unroll
    for (int j = 0; j < 4; ++j) { const f32x4 v = __builtin_nontemporal_load((const f32x4*)src + lane + 64 * j); if (dstf) *((f32x4*)dstf + lane + 64 * j) = v * fscale;
        u32x2 w; w.x = cvt_pk_bf16(v[0], v[1]); w.y = cvt_pk_bf16(v[2], v[3]); *((u32x2*)dstb + lane + 64 * j) = w; }
}
template <int NSLAB>
__device__ __forceinline__ void ln_row(float* xout, bf16_t* brow, const float* g, const float* b, int lane, const float* slab) {
    f32x4 v[4]; float s = 0.f;
    u32x2 xw[4];
#pragma unroll
    for (int j = 0; j < 4; ++j) xw[j] = *((const u32x2*)brow + lane + 64 * j);
    f32x4 sv[NSLAB][4];
#pragma unroll
    for (int k = 0; k < NSLAB; ++k)
#pragma unroll
        for (int j = 0; j < 4; ++j) sv[k][j] = *((const f32x4*)(slab + (size_t)k * TS * D) + lane + 64 * j);
#pragma unroll
    for (int j = 0; j < 4; ++j) v[j] = (f32x4){bf_lo(xw[j].x), bf_hi(xw[j].x), bf_lo(xw[j].y), bf_hi(xw[j].y)} * ALPHA;
#pragma unroll
    for (int k = 0; k < NSLAB; ++k)
#pragma unroll
        for (int j = 0; j < 4; ++j) v[j] += sv[k][j];
#pragma unroll
    for (int j = 0; j < 4; ++j) s += (v[j][0] + v[j][1]) + (v[j][2] + v[j][3]);
    const float mean = wave_sum(s) * (1.f / D); float s2 = 0.f;
#pragma unroll
    for (int j = 0; j < 4; ++j) { v[j] = v[j] - mean; s2 += (v[j][0] * v[j][0] + v[j][1] * v[j][1]) + (v[j][2] * v[j][2] + v[j][3] * v[j][3]); }
    const float rstd = 1.0f / sqrtf(wave_sum(s2) * (1.f / D) + LN_EPS);
#pragma unroll
    for (int j = 0; j < 4; ++j) { const f32x4 gg = *((const f32x4*)g + lane + 64 * j), bb = *((const f32x4*)b + lane + 64 * j);
        const f32x4 y = v[j] * rstd * gg + bb; if (xout) *((f32x4*)xout + lane + 64 * j) = y;
        u32x2 w; w.x = cvt_pk_bf16(y[0], y[1]); w.y = cvt_pk_bf16(y[2], y[3]); *((u32x2*)brow + lane + 64 * j) = w; }
}

__device__ __forceinline__ void attn_prompt_item(LAS unsigned char* lds, const bf16_t* Z, const bf16_t* KM, const bf16_t* VT, bf16_t* YC, int item, int tid) {
    const int b = item >> 5, h = (item >> 3) & 3, qb = item & 7;
    const int lane = tid & 63, w = tid >> 6, fr = lane & 15, fq = lane >> 4;
    LAS unsigned char* Ks = lds; LAS unsigned char* Vs = lds + 69632;
#pragma unroll
    for (int it = 0; it < 8; ++it) { const int idx = it * 512 + tid, row = idx >> 4, ch = idx & 15;
        const u32x4 v = *(const u32x4*)(KM + (size_t)(b * 256 + row) * 512 + h * 128 + ch * 8); *(LAS u32x4*)(Ks + row * 272 + ch * 16) = v; }
#pragma unroll
    for (int it = 0; it < 8; ++it) { const int idx = it * 512 + tid, d = idx >> 5, ch = idx & 31;
        const u32x4 v = *(const u32x4*)(VT + (size_t)(h * 128 + d) * 2048 + b * 256 + ch * 8); *(LAS u32x4*)(Vs + d * 528 + ch * 16) = v; }
    const size_t qrow0 = (size_t)b * 2048 + qb * 256 + w * 32 + fr;
    bf16x8 qf[2][4];
#pragma unroll
    for (int mt = 0; mt < 2; ++mt)
#pragma unroll
        for (int kk = 0; kk < 4; ++kk) qf[mt][kk] = *(const bf16x8*)(Z + (qrow0 + 16 * mt) * NIN + ZC_Q + h * 128 + kk * 32 + fq * 8);
    __syncthreads();
    f32x4 s[2][16];
#pragma unroll
    for (int mt = 0; mt < 2; ++mt)
#pragma unroll
        for (int n = 0; n < 16; ++n) s[mt][n] = (f32x4){0.f, 0.f, 0.f, 0.f};
#pragma unroll
    for (int n = 0; n < 16; ++n)
#pragma unroll
        for (int kk = 0; kk < 4; ++kk) { const bf16x8 kf = *(const LAS bf16x8*)(Ks + (16 * n + fr) * 272 + (32 * kk + 8 * fq) * 2);
            s[0][n] = __builtin_amdgcn_mfma_f32_16x16x32_bf16(kf, qf[0][kk], s[0][n], 0, 0, 0);
            s[1][n] = __builtin_amdgcn_mfma_f32_16x16x32_bf16(kf, qf[1][kk], s[1][n], 0, 0, 0);
            if (kk == 3 && (n & 1)) __builtin_amdgcn_sched_barrier(0); }
    bf16x8 pf[2][8];
#pragma unroll
    for (int mt = 0; mt < 2; ++mt) {
        float mx = -3.0e38f;
#pragma unroll
        for (int n = 0; n < 16; ++n) mx = fmaxf(mx, fmaxf(fmaxf(s[mt][n][0], s[mt][n][1]), fmaxf(s[mt][n][2], s[mt][n][3])));
        mx = fmaxf(mx, __shfl_xor(mx, 16)); mx = fmaxf(mx, __shfl_xor(mx, 32));
        const float c2 = 0.08838834764831845f * 1.4426950408889634f; float sum = 0.f;
#pragma unroll
        for (int n = 0; n < 16; ++n)
#pragma unroll
            for (int j = 0; j < 4; ++j) { const float e = __builtin_amdgcn_exp2f((s[mt][n][j] - mx) * c2); s[mt][n][j] = e; sum += e; }
        sum += __shfl_xor(sum, 16); sum += __shfl_xor(sum, 32);
        const float inv = 1.0f / sum;
#pragma unroll
        for (int k2 = 0; k2 < 8; ++k2) { u32x4 t; t.x = cvt_pk_bf16(s[mt][2 * k2][0] * inv, s[mt][2 * k2][1] * inv); t.y = cvt_pk_bf16(s[mt][2 * k2][2] * inv, s[mt][2 * k2][3] * inv);
            t.z = cvt_pk_bf16(s[mt][2 * k2 + 1][0] * inv, s[mt][2 * k2 + 1][1] * inv); t.w = cvt_pk_bf16(s[mt][2 * k2 + 1][2] * inv, s[mt][2 * k2 + 1][3] * inv); pf[mt][k2] = __builtin_bit_cast(bf16x8, t); }
        __builtin_amdgcn_sched_barrier(0);
    }
    f32x4 o[2][8];
#pragma unroll
    for (int mt = 0; mt < 2; ++mt)
#pragma unroll
        for (int nd = 0; nd < 8; ++nd) o[mt][nd] = (f32x4){0.f, 0.f, 0.f, 0.f};
#pragma unroll
    for (int k2 = 0; k2 < 8; ++k2)
#pragma unroll
        for (int nd = 0; nd < 8; ++nd) { const bf16x8 vf = *(const LAS bf16x8*)(Vs + (16 * nd + fr) * 528 + (32 * k2 + 8 * fq) * 2);
            o[0][nd] = __builtin_amdgcn_mfma_f32_16x16x32_bf16(vf, pf[0][k2], o[0][nd], 0, 0, 0);
            o[1][nd] = __builtin_amdgcn_mfma_f32_16x16x32_bf16(vf, pf[1][k2], o[1][nd], 0, 0, 0);
            if (nd == 7) __builtin_amdgcn_sched_barrier(0); }
#pragma unroll
    for (int mt = 0; mt < 2; ++mt)
#pragma unroll
        for (int nd = 0; nd < 8; ++nd) { u32x2 wv; wv.x = cvt_pk_bf16(o[mt][nd][0], o[mt][nd][1]); wv.y = cvt_pk_bf16(o[mt][nd][2], o[mt][nd][3]);
            *(u32x2*)(YC + (qrow0 + 16 * mt) * (3 * CW) + h * 128 + 16 * nd + 4 * fq) = wv; }
    __syncthreads();
}

__device__ __forceinline__ void attn_sample_item(LAS unsigned char* lds, const bf16_t* Z, const float* CK, const float* CV, bf16_t* YC, int item, int tid) {
    const int b = item >> 2, h = item & 3;
    const int lane = tid & 63, w = tid >> 6;
    LAS float* S = (LAS float*)lds;
    LAS float* P = (LAS float*)(lds + 4096);
    LAS float* R = (LAS float*)(lds + 8192);
    {
        const int g = lane >> 4, i = lane & 15;
        u32x4 qraw[4];
#pragma unroll
        for (int qi = 0; qi < 4; ++qi) qraw[qi] = *(const u32x4*)(Z + (size_t)(TP + b * 4 + qi) * NIN + ZC_Q + h * 128 + 8 * i);
        const float* kbase = CK + ((size_t)(b * 256) * 4 + h) * 128 + 8 * i;
        f32x4 k0[8], k1[8];
#pragma unroll
        for (int it = 0; it < 8; ++it) { const int key = 32 * w + 4 * it + g; const float* pk = kbase + (size_t)key * 512; k0[it] = *(const f32x4*)pk; k1[it] = *(const f32x4*)(pk + 4); }
        float qv[4][8];
#pragma unroll
        for (int qi = 0; qi < 4; ++qi) unpack8(qraw[qi], qv[qi]);
#pragma unroll
        for (int it = 0; it < 8; ++it) { const int key = 32 * w + 4 * it + g;
#pragma unroll
            for (int qi = 0; qi < 4; ++qi) {
                float sv = k0[it][0] * qv[qi][0] + k0[it][1] * qv[qi][1] + k0[it][2] * qv[qi][2] + k0[it][3] * qv[qi][3]
                         + k1[it][0] * qv[qi][4] + k1[it][1] * qv[qi][5] + k1[it][2] * qv[qi][6] + k1[it][3] * qv[qi][7];
                sv += __shfl_xor(sv, 1); sv += __shfl_xor(sv, 2); sv += __shfl_xor(sv, 4); sv += __shfl_xor(sv, 8);
                if (i == 0) S[qi * 256 + key] = sv * 0.08838834764831845f;
            }
        }
    }
    __syncthreads();
    if (w < 4) {
        float v[4]; float mx = -3.0e38f;
#pragma unroll
        for (int j = 0; j < 4; ++j) { v[j] = S[w * 256 + lane + 64 * j]; mx = fmaxf(mx, v[j]); }
        mx = wave_max(mx); float sum = 0.f;
#pragma unroll
        for (int j = 0; j < 4; ++j) { v[j] = __expf(v[j] - mx); sum += v[j]; }
        sum = wave_sum(sum); const float inv = 1.0f / sum;
#pragma unroll
        for (int j = 0; j < 4; ++j) P[(lane + 64 * j) * 4 + w] = v[j] * inv;
    }
    {
        const int dq = tid & 31, kg = tid >> 5;
        const float* vbase = CV + ((size_t)(b * 256 + 16 * kg) * 4 + h) * 128 + 4 * dq;
        f32x4 vv[16];
#pragma unroll
        for (int key = 0; key < 16; ++key) vv[key] = *(const f32x4*)(vbase + (size_t)key * 512);
        __syncthreads();
        f32x4 a0 = (f32x4){0.f, 0.f, 0.f, 0.f}, a1 = a0, a2 = a0, a3 = a0;
#pragma unroll
        for (int key = 0; key < 16; ++key) { const f32x4 pp = *(const LAS f32x4*)(P + (16 * kg + key) * 4);
            a0 += vv[key] * pp[0]; a1 += vv[key] * pp[1]; a2 += vv[key] * pp[2]; a3 += vv[key] * pp[3]; }
        *(LAS f32x4*)(R + (kg * 4 + 0) * 128 + 4 * dq) = a0; *(LAS f32x4*)(R + (kg * 4 + 1) * 128 + 4 * dq) = a1;
        *(LAS f32x4*)(R + (kg * 4 + 2) * 128 + 4 * dq) = a2; *(LAS f32x4*)(R + (kg * 4 + 3) * 128 + 4 * dq) = a3;
    }
    __syncthreads();
    { const int qi = tid >> 7, d = tid & 127; float o = 0.f;
#pragma unroll
      for (int kg = 0; kg < 16; ++kg) o += R[(kg * 4 + qi) * 128 + d];
      YC[(size_t)(TP + b * 4 + qi) * (3 * CW) + h * 128 + d] = (bf16_t)(cvt_pk_bf16(o, 0.f) & 0xffffu); }
    __syncthreads();
}

struct ZRows { u32x4 a0, b0, a1, b1, a2, b2, a3, b3; };
__device__ __forceinline__ ZRows lru_zload(const bf16_t* Z, int item, int tid) {
    const int rt = item >> 3, n = item & 7, i = tid >> 2, c = n * 64 + (tid & 3) * 16;
    const size_t row = (size_t)rt * 128 + i;
    const int t = (rt < 128) ? (rt & 15) * 128 + i : (i & 3);
    const bf16_t* z0 = Z + row * NIN + ZC_LX + c;
    const bf16_t* z1 = (t >= 1) ? z0 - NIN : z0; const bf16_t* z2 = (t >= 2) ? z0 - 2 * NIN : z0; const bf16_t* z3 = (t >= 3) ? z0 - 3 * NIN : z0;
    ZRows r;
    r.a0 = *(const u32x4*)z0; r.b0 = *(const u32x4*)(z0 + 8); r.a1 = *(const u32x4*)z1; r.b1 = *(const u32x4*)(z1 + 8);
    r.a2 = *(const u32x4*)z2; r.b2 = *(const u32x4*)(z2 + 8); r.a3 = *(const u32x4*)z3; r.b3 = *(const u32x4*)(z3 + 8);
    return r;
}
__device__ __forceinline__ void lru_item(LAS unsigned char* lds, CP p, int l, const bf16_t* Z, const bf16_t* LWA, const bf16_t* LWX,
                                         float* ACUM, float* BCUM, float* AGG, bf16_t* YB, int item, int tid, const ZRows zin, bool fill_prm) {
    const int rt = item >> 3, n = item & 7;
    const bool samp = rt >= 128;
    LAS float* XC = (LAS float*)lds;
    LAS float* BB = (LAS float*)(lds + 34816);
    LAS unsigned char* XCB = lds + 69632;
    LAS unsigned char* WA = lds + 88064;
    LAS unsigned char* WX = lds + 97280;
    LAS float* SEGA = (LAS float*)(lds + 106496);
    LAS float* SEGB = (LAS float*)(lds + 108544);
    LAS float* PRM = (LAS float*)(lds + 110592);
    if (fill_prm) {
        const int r = tid >> 6, ch = tid & 63, cglob = l * 512 + n * 64 + ch;
        float v;
        if (r == 0) v = p->in[26][cglob]; else if (r == 1) v = p->in[28][cglob]; else if (r == 2) v = softplus_neg_(p->in[29][cglob]);
        else if (r == 3) v = p->in[24][cglob]; else v = p->in[23][(size_t)(l * 4 + 3 - (r - 4)) * 512 + n * 64 + ch];
        PRM[r * 64 + ch] = v;
        __syncthreads();
    }
    {
        const int i = tid >> 2, cgp = tid & 3, c = n * 64 + cgp * 16;
        const size_t row = (size_t)rt * 128 + i;
        int t, bb;
        if (!samp) { bb = rt >> 4; t = (rt & 15) * 128 + i; } else { bb = (rt - 128) * 32 + (i >> 2); t = i & 3; }
        float xv[16];
#pragma unroll
        for (int e4 = 0; e4 < 4; ++e4) { const f32x4 bq = *(const LAS f32x4*)(PRM + 3 * 64 + cgp * 16 + 4 * e4); xv[4 * e4] = bq[0]; xv[4 * e4 + 1] = bq[1]; xv[4 * e4 + 2] = bq[2]; xv[4 * e4 + 3] = bq[3]; }
#pragma unroll
        for (int k = 0; k < 4; ++k) {
            float lxv[16];
            { const u32x4 za = (k == 0) ? zin.a0 : (k == 1) ? zin.a1 : (k == 2) ? zin.a2 : zin.a3, zb = (k == 0) ? zin.b0 : (k == 1) ? zin.b1 : (k == 2) ? zin.b2 : zin.b3;
              float f0[8], f1[8]; unpack8(za, f0); unpack8(zb, f1);
#pragma unroll
              for (int e = 0; e < 8; ++e) { lxv[e] = f0[e]; lxv[8 + e] = f1[e]; } }
            if (t - k < 0) {
#pragma unroll
                for (int e = 0; e < 16; ++e) lxv[e] = 0.f;
                if (samp) { const float* sp = p->in[5] + ((size_t)(l * 128 + bb) * 3 + (3 + t - k)) * 512 + c;
#pragma unroll
                    for (int e4 = 0; e4 < 4; ++e4) { const f32x4 v = *(const f32x4*)(sp + 4 * e4); lxv[4 * e4] = v[0]; lxv[4 * e4 + 1] = v[1]; lxv[4 * e4 + 2] = v[2]; lxv[4 * e4 + 3] = v[3]; } }
            }
#pragma unroll
            for (int e4 = 0; e4 < 4; ++e4) { const f32x4 wq = *(const LAS f32x4*)(PRM + (4 + k) * 64 + cgp * 16 + 4 * e4);
                xv[4 * e4] += wq[0] * lxv[4 * e4]; xv[4 * e4 + 1] += wq[1] * lxv[4 * e4 + 1]; xv[4 * e4 + 2] += wq[2] * lxv[4 * e4 + 2]; xv[4 * e4 + 3] += wq[3] * lxv[4 * e4 + 3]; }
            if (k == 0) {
                float* so = nullptr;
                if (!samp) { if (t >= 2045) so = p->out + O_PLCONV + ((size_t)(l * 8 + bb) * 3 + (t - 2045)) * 512 + c; }
                else { if (t >= 1) so = p->out + O_SLCONV + ((size_t)(l * 128 + bb) * 3 + (t - 1)) * 512 + c; }
                if (so) {
#pragma unroll
                    for (int e = 0; e < 16; e += 4) *(f32x4*)(so + e) = (f32x4){lxv[e], lxv[e + 1], lxv[e + 2], lxv[e + 3]};
                }
            }
        }
#pragma unroll
        for (int e = 0; e < 16; e += 4) *(LAS f32x4*)(XC + i * 68 + cgp * 16 + e) = (f32x4){xv[e], xv[e + 1], xv[e + 2], xv[e + 3]};
        u32x4 w0, w1;
        w0.x = cvt_pk_bf16(xv[0], xv[1]); w0.y = cvt_pk_bf16(xv[2], xv[3]); w0.z = cvt_pk_bf16(xv[4], xv[5]); w0.w = cvt_pk_bf16(xv[6], xv[7]);
        w1.x = cvt_pk_bf16(xv[8], xv[9]); w1.y = cvt_pk_bf16(xv[10], xv[11]); w1.z = cvt_pk_bf16(xv[12], xv[13]); w1.w = cvt_pk_bf16(xv[14], xv[15]);
        *(LAS u32x4*)(XCB + i * 144 + cgp * 32) = w0; *(LAS u32x4*)(XCB + i * 144 + cgp * 32 + 16) = w1;
        const int j = tid >> 3, ch = tid & 7;
        *(LAS u32x4*)(WA + j * 144 + ch * 16) = *(const u32x4*)(LWA + (size_t)j * 512 + n * 64 + ch * 8);
        *(LAS u32x4*)(WX + j * 144 + ch * 16) = *(const u32x4*)(LWX + (size_t)j * 512 + n * 64 + ch * 8);
    }
    __syncthreads();
    {
        const int lane = tid & 63, w = tid >> 6, fr = lane & 15, fq = lane >> 4;
        bf16x8 af[2];
#pragma unroll
        for (int ks = 0; ks < 2; ++ks) af[ks] = *(const LAS bf16x8*)(XCB + (16 * w + fr) * 144 + (32 * ks + 8 * fq) * 2);
        f32x4 ra[4], ri[4];
#pragma unroll
        for (int nt = 0; nt < 4; ++nt) { ra[nt] = (f32x4){0.f, 0.f, 0.f, 0.f}; ri[nt] = (f32x4){0.f, 0.f, 0.f, 0.f}; }
#pragma unroll
        for (int nt = 0; nt < 4; ++nt)
#pragma unroll
            for (int ks = 0; ks < 2; ++ks) {
                const bf16x8 wa = *(const LAS bf16x8*)(WA + (16 * nt + fr) * 144 + (32 * ks + 8 * fq) * 2);
                const bf16x8 wx = *(const LAS bf16x8*)(WX + (16 * nt + fr) * 144 + (32 * ks + 8 * fq) * 2);
                ra[nt] = __builtin_amdgcn_mfma_f32_16x16x32_bf16(wa, af[ks], ra[nt], 0, 0, 0);
                ri[nt] = __builtin_amdgcn_mfma_f32_16x16x32_bf16(wx, af[ks], ri[nt], 0, 0, 0);
            }
#pragma unroll
        for (int nt = 0; nt < 4; ++nt) {
            const int chn = 16 * nt + 4 * fq;
            LAS f32x4* xp = (LAS f32x4*)(XC + (16 * w + fr) * 68 + chn);
            const f32x4 xc4 = *xp;
            const f32x4 ba4 = *(const LAS f32x4*)(PRM + chn), bx4 = *(const LAS f32x4*)(PRM + 64 + chn), sp4 = *(const LAS f32x4*)(PRM + 128 + chn);
            f32x4 a4, b4;
#pragma unroll
            for (int j = 0; j < 4; ++j) {
                const float r = sigmoidf_(ra[nt][j] + ba4[j]), ig = sigmoidf_(ri[nt][j] + bx4[j]);
                const float la = -8.0f * r * sp4[j];
                a4[j] = __expf(la);
                b4[j] = __builtin_amdgcn_sqrtf(one_minus_exp_(2.0f * la)) * ig * xc4[j];
            }
            *xp = a4; *(LAS f32x4*)(BB + (16 * w + fr) * 68 + chn) = b4;
        }
    }
    __syncthreads();
    const int c = tid & 63, sg = tid >> 6;
    if (!samp) {
        float A = 1.f, B = 0.f;
#pragma unroll
        for (int tt = 0; tt < 16; ++tt) { const float a = XC[(16 * sg + tt) * 68 + c], b = BB[(16 * sg + tt) * 68 + c]; B = a * B + b; A *= a; }
        SEGA[sg * 64 + c] = A; SEGB[sg * 64 + c] = B;
    }
    __syncthreads();
    {
        float A = 1.f, B = 0.f;
        if (!samp) for (int s2 = 0; s2 < sg; ++s2) { const float sa = SEGA[s2 * 64 + c], sb = SEGB[s2 * 64 + c]; B = sa * B + sb; A *= sa; }
        const size_t base = ((size_t)rt * 128 + 16 * sg) * CW + n * 64 + c;
        if (!samp) {
#pragma unroll
            for (int tt = 0; tt < 16; ++tt) {
                const float a = XC[(16 * sg + tt) * 68 + c], b = BB[(16 * sg + tt) * 68 + c]; B = a * B + b; A *= a;
                const unsigned ab = cvt_pk_bf16(A, B);
                ((bf16_t*)ACUM)[base + (size_t)tt * CW] = (bf16_t)(ab & 0xffffu); ((bf16_t*)BCUM)[base + (size_t)tt * CW] = (bf16_t)(ab >> 16);
            }
            if (sg == 7) { float* ag = AGG + ((size_t)rt * 512 + n * 64 + c) * 2; ag[0] = A; ag[1] = B; }
        } else {
            float h = 0.f;
#pragma unroll
            for (int tt = 0; tt < 16; ++tt) {
                const int tok = 16 * sg + tt, bs = (rt - 128) * 32 + (tok >> 2);
                if ((tt & 3) == 0) h = p->in[6][(size_t)(l * 128 + bs) * 512 + n * 64 + c];
                const float a = XC[tok * 68 + c], b = BB[tok * 68 + c]; h = a * h + b;
                const size_t row = (size_t)rt * 128 + tok;
                const float lg = bf2f(Z[row * NIN + ZC_LG + n * 64 + c]);
                YB[row * (3 * CW) + n * 64 + c] = (bf16_t)(cvt_pk_bf16(h * lg, 0.f) & 0xffffu);
                if ((tt & 3) == 3) p->out[O_SH + (size_t)(l * 128 + bs) * 512 + n * 64 + c] = h;
            }
        }
    }
    __syncthreads();
}

__device__ __forceinline__ void conv_item(CP p, int l, const bf16_t* Z, bf16_t* YA, int ct, int tid) {
    const int rt = ct >> 2;
    const bool samp = rt >= 128;
#pragma unroll 2
    for (int it = 0; it < 4; ++it) {
        const int idx = it * 512 + tid, i = (ct & 3) * 32 + (idx >> 6), c = (idx & 63) * 8;
        const size_t row = (size_t)rt * 128 + i;
        int t, bb;
        if (!samp) { bb = rt >> 4; t = (rt & 15) * 128 + i; } else { bb = (rt - 128) * 32 + (i >> 2); t = i & 3; }
        u32x4 cvr[3], ccr[3]; f32x4 wq[3][2], stq[3][2];
#pragma unroll
        for (int k = 0; k < 3; ++k) { const size_t rk = (t - k >= 0) ? row - k : row; const bf16_t* zp = Z + rk * NIN; cvr[k] = *(const u32x4*)(zp + ZC_CV + c); ccr[k] = *(const u32x4*)(zp + ZC_CC + c); }
        const u32x4 cbr = *(const u32x4*)(Z + row * NIN + ZC_CB + c);
#pragma unroll
        for (int k = 0; k < 3; ++k) { const float* wp = p->in[21] + (size_t)(l * 3 + 2 - k) * 512 + c; wq[k][0] = *(const f32x4*)wp; wq[k][1] = *(const f32x4*)(wp + 4);
            stq[k][0] = (f32x4){0.f, 0.f, 0.f, 0.f}; stq[k][1] = stq[k][0]; }
        if (samp) {
#pragma unroll
            for (int k = 1; k < 3; ++k) { int si = 2 + t - k; si = si < 0 ? 0 : (si > 1 ? 1 : si);
                const float* sp = p->in[4] + ((size_t)(l * 128 + bb) * 2 + si) * 512 + c; stq[k][0] = *(const f32x4*)sp; stq[k][1] = *(const f32x4*)(sp + 4); }
        }
        float uacc[8];
#pragma unroll
        for (int e = 0; e < 8; ++e) uacc[e] = 0.f;
#pragma unroll
        for (int k = 0; k < 3; ++k) {
            float pv[8];
            { float a[8], bq[8]; unpack8(cvr[k], a); unpack8(ccr[k], bq);
#pragma unroll
              for (int e = 0; e < 8; ++e) pv[e] = a[e] * bq[e]; }
            if (t - k < 0) { pv[0] = stq[k][0][0]; pv[1] = stq[k][0][1]; pv[2] = stq[k][0][2]; pv[3] = stq[k][0][3]; pv[4] = stq[k][1][0]; pv[5] = stq[k][1][1]; pv[6] = stq[k][1][2]; pv[7] = stq[k][1][3]; }
            const f32x4 w0 = wq[k][0], w1 = wq[k][1];
            uacc[0] += w0[0] * pv[0]; uacc[1] += w0[1] * pv[1]; uacc[2] += w0[2] * pv[2]; uacc[3] += w0[3] * pv[3];
            uacc[4] += w1[0] * pv[4]; uacc[5] += w1[1] * pv[5]; uacc[6] += w1[2] * pv[6]; uacc[7] += w1[3] * pv[7];
            if (k == 0) {
                float* so = nullptr;
                if (!samp) { if (t >= 2046) so = p->out + O_PCONV + ((size_t)(l * 8 + bb) * 2 + (t - 2046)) * 512 + c; }
                else { if (t >= 2) so = p->out + O_SCONV + ((size_t)(l * 128 + bb) * 2 + (t - 2)) * 512 + c; }
                if (so) { *(f32x4*)so = (f32x4){pv[0], pv[1], pv[2], pv[3]}; *(f32x4*)(so + 4) = (f32x4){pv[4], pv[5], pv[6], pv[7]}; }
            }
        }
        float cbv[8]; unpack8(cbr, cbv);
        u32x4 wv; wv.x = cvt_pk_bf16(cbv[0] * uacc[0], cbv[1] * uacc[1]); wv.y = cvt_pk_bf16(cbv[2] * uacc[2], cbv[3] * uacc[3]);
        wv.z = cvt_pk_bf16(cbv[4] * uacc[4], cbv[5] * uacc[5]); wv.w = cvt_pk_bf16(cbv[6] * uacc[6], cbv[7] * uacc[7]);
        *(u32x4*)(YA + row * (3 * CW) + c) = wv;
    }
}

__device__ __forceinline__ void lru_apply_item(CP p, int l, const bf16_t* Z, const float* ACUM, const float* BCUM, const float* AGG, bf16_t* YB, int rt, int tid) {
    const bool samp = rt >= 128;
    const int c = (tid & 127) * 4, ro = tid >> 7;
    f32x4 carry = (f32x4){0.f, 0.f, 0.f, 0.f};
    const int bb0 = rt >> 4, jc = rt & 15;
    if (!samp) {
        f32x4 q0[15], q1[15];
#pragma unroll
        for (int jj = 0; jj < 15; ++jj) { const float* ag = AGG + ((size_t)(bb0 * 16 + (jj < jc ? jj : 0)) * 512 + c) * 2; q0[jj] = *(const f32x4*)ag; q1[jj] = *(const f32x4*)(ag + 4); }
#pragma unroll
        for (int jj = 0; jj < 15; ++jj) if (jj < jc) {
            carry[0] = q0[jj][0] * carry[0] + q0[jj][1]; carry[1] = q0[jj][2] * carry[1] + q0[jj][3]; carry[2] = q1[jj][0] * carry[2] + q1[jj][1]; carry[3] = q1[jj][2] * carry[3] + q1[jj][3]; }
    }
#pragma unroll 8
    for (int it = 0; it < 32; ++it) {
        const int i = ro + 4 * it; const size_t row = (size_t)rt * 128 + i;
        int bs = 0;
        if (samp) { bs = (rt - 128) * 32 + (i >> 2); carry = *(const f32x4*)(p->in[6] + (size_t)(l * 128 + bs) * 512 + c); }
        const u32x2 aw = *(const u32x2*)((const bf16_t*)ACUM + row * CW + c), bw = *(const u32x2*)((const bf16_t*)BCUM + row * CW + c);
        const f32x4 a4 = (f32x4){bf_lo(aw.x), bf_hi(aw.x), bf_lo(aw.y), bf_hi(aw.y)}, b4 = (f32x4){bf_lo(bw.x), bf_hi(bw.x), bf_lo(bw.y), bf_hi(bw.y)};
        const f32x4 h = a4 * carry + b4;
        const u32x2 gw = *(const u32x2*)(Z + row * NIN + ZC_LG + c);
        u32x2 wv; wv.x = cvt_pk_bf16(h[0] * bf_lo(gw.x), h[1] * bf_hi(gw.x)); wv.y = cvt_pk_bf16(h[2] * bf_lo(gw.y), h[3] * bf_hi(gw.y));
        *(u32x2*)(YB + row * (3 * CW) + c) = wv;
        if (!samp) { if (jc == 15 && i == 127) *(f32x4*)(p->out + O_PH + (size_t)(l * 8 + bb0) * 512 + c) = h; }
        else { if ((i & 3) == 3) *(f32x4*)(p->out + O_SH + (size_t)(l * 128 + bs) * 512 + c) = h; }
    }
}


#define XB_TMO      128
#define XB_XCNT(j)  (256  + 64 * (j))
#define XB_XSUB(j)  (1280 + 64 * (j))
#define XB_XGEN(j)  (2304 + 64 * (j))
#define XB_TOP      3328
#define XB_TOPGEN   3392
#define XCD_BAR_WORDS 3456
#define XB_SPIN_CAP (1u << 20)
__device__ __forceinline__ unsigned xb_ld(unsigned* p)              { return __hip_atomic_load(p, __ATOMIC_RELAXED, __HIP_MEMORY_SCOPE_AGENT); }
__device__ __forceinline__ unsigned xb_add(unsigned* p, unsigned v) { return __hip_atomic_fetch_add(p, v, __ATOMIC_RELAXED, __HIP_MEMORY_SCOPE_AGENT); }
__device__ __forceinline__ unsigned xb_xcc_id() { return (unsigned)__builtin_amdgcn_s_getreg((3 << 11) | 20) & 0xFu; }
#define XB_SPIN(cond, bar) do { unsigned _sp = 0; while (cond) { __builtin_amdgcn_s_sleep(1); \
    if ((++_sp & 255u) == 0u) { if (xb_ld(&(bar)[XB_TMO])) break; if (_sp > XB_SPIN_CAP) { atomicAdd(&(bar)[XB_TMO], 1u); break; } } } } while (0)
struct XcdBarrier { unsigned* bar; unsigned x; volatile LAS unsigned* st; };
__device__ __forceinline__ XcdBarrier xcd_barrier_post(unsigned* bar, volatile LAS unsigned* st) {
    XcdBarrier b; b.bar = bar; b.x = xb_xcc_id(); b.st = st;
    if (threadIdx.x == 0) (void)xb_add(&bar[XB_XCNT(b.x)], 1u);
    return b;
}
__device__ __forceinline__ void xcd_barrier_complete(unsigned* bar, unsigned x, unsigned& nloc, unsigned& nx) {
    const unsigned G = gridDim.x * gridDim.y * gridDim.z;
    unsigned sum, cnt, mine, sp = 0u;
    for (;;) {
        sum = 0u; cnt = 0u; mine = 0u;
#pragma unroll
        for (unsigned j = 0; j < 16; ++j) { const unsigned c = xb_ld(&bar[XB_XCNT(j)]); sum += c; cnt += (c > 0u) ? 1u : 0u; mine = (j == x) ? c : mine; }
        if (sum == G) break;
        __builtin_amdgcn_s_sleep(1);
        if ((++sp & 255u) == 0u) { if (xb_ld(&bar[XB_TMO])) break; if (sp > XB_SPIN_CAP) { atomicAdd(&bar[XB_TMO], 1u); break; } }
    }
    nloc = mine > 0u ? mine : 1u; nx = cnt > 0u ? cnt : 1u;
}
__device__ __forceinline__ void xcd_barrier(const XcdBarrier& b) {
    asm volatile("s_waitcnt vmcnt(0)" ::: "memory");
    __syncthreads();
    if (threadIdx.x == 0) {
        unsigned* bar = b.bar;
        __builtin_amdgcn_s_waitcnt(0);
        unsigned nloc = b.st[0], nx = b.st[1];
        if (nloc == 0u) { xcd_barrier_complete(bar, b.x, nloc, nx); b.st[0] = nloc; b.st[1] = nx; }
        const unsigned old = xb_add(&bar[XB_XSUB(b.x)], 1u);
        const unsigned gen = old / nloc;
        if (old + 1u == (gen + 1u) * nloc) {
            __builtin_amdgcn_fence(__ATOMIC_RELEASE, "agent");
            asm volatile("s_waitcnt vmcnt(0)" ::: "memory");
            const unsigned og = xb_add(&bar[XB_TOP], 1u);
            const unsigned tg = og / nx;
            if (og + 1u == (tg + 1u) * nx) xb_add(&bar[XB_TOPGEN], 1u);
            else XB_SPIN(xb_ld(&bar[XB_TOPGEN]) == tg, bar);
            __builtin_amdgcn_fence(__ATOMIC_ACQUIRE, "agent");
            xb_add(&bar[XB_XGEN(b.x)], 1u);
            asm volatile("s_waitcnt vmcnt(0)" ::: "memory");
        } else {
            XB_SPIN(xb_ld(&bar[XB_XGEN(b.x)]) == gen, bar);
            __builtin_amdgcn_fence(__ATOMIC_ACQUIRE, "agent");
            asm volatile("s_waitcnt vmcnt(0)" ::: "memory");
        }
    }
    __syncthreads();
}

#define WSP(q, off) ((q)->ws + (off))
__global__ void __launch_bounds__(512, 2) mega(Params p_unused) {
    extern __shared__ __attribute__((aligned(16))) unsigned char lds_raw[];
    LAS unsigned char* lds = (LAS unsigned char*)lds_raw;
    cg::grid_group grid = cg::this_grid();
    const int G = gridDim.x, blk = blockIdx.x;
    constexpr int LDS_ST = LDS_BYTES - 64;
    if (threadIdx.x < 16) ((volatile LAS unsigned*)(lds + LDS_ST))[threadIdx.x] = 0u;
    XcdBarrier xb;
    { CP p = kp(); xb = xcd_barrier_post((unsigned*)p->ws, (volatile LAS unsigned*)(lds + LDS_ST));
      if (p->ws == nullptr) grid.sync(); }
#define GRID_SYNC() xcd_barrier(xb)

    {
        CP p = kp(); const int tid = tid_(), lane = tid & 63, wave = __builtin_amdgcn_readfirstlane(tid >> 6);
        unsigned char* ws = p->ws;
        LAS float* scr = (LAS float*)(lds + wave * 16384);
        const int gw = blk * 8 + wave, NGW = G * 8;
        constexpr int I_F = 1408, I_IN = 3072, I_BR = 256, I_O = 512, I_LR = 16, I_KV = 256;
        constexpr int PER_L = 6 * I_F + I_IN + 3 * I_BR + I_O + 2 * I_LR + 2 * I_KV;
        bf16_t* WKV = (bf16_t*)(ws + WS_WKV);
        for (int it = gw; it < 2 * PER_L; it += NGW) {
            const int l = it / PER_L; int r = it - l * PER_L;
            unsigned char* wl = ws + WS_W + (size_t)l * WL_SIZE;
            const size_t fo = (size_t)l * D * FF;
            if (r < I_F) { transpose_item(p->in[14] + fo, FF, (bf16_t*)(wl + WL_GU1), D, 0, 1, scr, r, lane); continue; } r -= I_F;
            if (r < I_F) { transpose_item(p->in[15] + fo, FF, (bf16_t*)(wl + WL_GU1), D, 0, 2, scr, r, lane); continue; } r -= I_F;
            if (r < I_F) { transpose_item(p->in[16] + fo, D, (bf16_t*)(wl + WL_D1), FF, 0, 0, scr, r, lane); continue; } r -= I_F;
            if (r < I_F) { transpose_item(p->in[17] + fo, FF, (bf16_t*)(wl + WL_GU2), D, 0, 1, scr, r, lane); continue; } r -= I_F;
            if (r < I_F) { transpose_item(p->in[18] + fo, FF, (bf16_t*)(wl + WL_GU2), D, 0, 2, scr, r, lane); continue; } r -= I_F;
            if (r < I_F) { transpose_item(p->in[19] + fo, D, (bf16_t*)(wl + WL_D2), FF, 0, 0, scr, r, lane); continue; } r -= I_F;
            if (r < I_IN) { transpose_item(p->in[20] + (size_t)l * D * NIN, NIN, (bf16_t*)(wl + WL_IN), D, 0, 0, scr, r, lane); continue; } r -= I_IN;
            if (r < I_BR) { transpose_item(p->in[22] + (size_t)l * CW * D, D, (bf16_t*)(wl + WL_BR), 3 * CW, 0, 0, scr, r, lane); continue; } r -= I_BR;
            if (r < I_BR) { transpose_item(p->in[30] + (size_t)l * CW * D, D, (bf16_t*)(wl + WL_BR) + CW, 3 * CW, 0, 0, scr, r, lane); continue; } r -= I_BR;
            if (r < I_BR) { transpose_item(p->in[33] + (size_t)l * CW * D, D, (bf16_t*)(wl + WL_BR) + 2 * CW, 3 * CW, 0, 0, scr, r, lane); continue; } r -= I_BR;
            if (r < I_O) { transpose_item(p->in[34] + (size_t)l * D * D, D, (bf16_t*)(wl + WL_O), D, 0, 0, scr, r, lane); continue; } r -= I_O;
            if (r < I_LR) { transpose_item(p->in[25] + (size_t)l * 512 * 64, 64, (bf16_t*)(wl + WL_LWA), 512, 0, 0, scr, r, lane); continue; } r -= I_LR;
            if (r < I_LR) { transpose_item(p->in[27] + (size_t)l * 512 * 64, 64, (bf16_t*)(wl + WL_LWX), 512, 0, 0, scr, r, lane); continue; } r -= I_LR;
            if (r < I_KV) { transpose_item(p->in[31] + (size_t)l * D * CW, CW, WKV, D, l * 1024, 0, scr, r, lane); continue; } r -= I_KV;
            transpose_item(p->in[32] + (size_t)l * D * CW, CW, WKV, D, l * 1024 + 512, 0, scr, r, lane);
        }
        float* X = p->out + O_Y; bf16_t* XB = (bf16_t*)(ws + WS_XB); bf16_t* MEMB = (bf16_t*)(ws + WS_MEMB);
        for (int m = gw; m < T + 2048; m += NGW) {
            if (m < TP) row_cvt(p->in[0] + (size_t)m * D, nullptr, XB + (size_t)m * D, lane, 1.0f);
            else if (m < T) row_cvt(p->in[1] + (size_t)(m - TP) * D, nullptr, XB + (size_t)m * D, lane, 1.0f);
            else row_cvt(p->in[7] + (size_t)(m - T) * D, nullptr, MEMB + (size_t)(m - T) * D, lane, 1.0f);
        }
    }
    GRID_SYNC();

    {
        CP p = kp();
        pg8::Gemm g{(const bf16_t*)WSP(p, WS_MEMB), (const bf16_t*)WSP(p, WS_WKV), 2048, 2048, D}; pg8::StaticOrder S; S.init(2048, 2048, D, G, (blk + 84) % G);
        EpiKV E{p->out, (bf16_t*)WSP(p, WS_KMEM), (bf16_t*)WSP(p, WS_VT)};
        pg8::gemm_phase<EpiKV, pg8::StaticOrder>(lds, g, S, E);
    }

#pragma unroll 1
    for (int s = 0; s < 4; ++s) {
        const int l = s >> 1, half = s & 1;
        {
            CP p = kp(); unsigned char* wl = WSP(p, WS_W + (size_t)l * WL_SIZE);
            pg8::Gemm g{(const bf16_t*)WSP(p, WS_XB), (const bf16_t*)(wl + (half ? WL_GU2 : WL_GU1)), T, 2 * FF, D}; pg8::StaticOrder S; S.init(T, 2 * FF, D, G, blk);
            EpiGU E{(bf16_t*)WSP(p, WS_HZ)};
            pg8::gemm_phase<EpiGU, pg8::StaticOrder>(lds, g, S, E);
        }
        GRID_SYNC();
        {
            CP p = kp(); unsigned char* wl = WSP(p, WS_W + (size_t)l * WL_SIZE);
            pg8::Gemm g{(const bf16_t*)WSP(p, WS_HZ), (const bf16_t*)(wl + (half ? WL_D2 : WL_D1)), T, D, FF}; pg8::TailOrder S; S.init(D, FF, G, blk, 11);
            EpiRes<true> E; E.Xout = (s == 3) ? p->out + O_Y : nullptr; E.slab = (float*)WSP(p, WS_ACUM);
            E.lng = (half ? p->in[12] : p->in[8]) + l * D; E.lnb = (half ? p->in[13] : p->in[9]) + l * D; E.cnt = (unsigned*)p->ws + CW_CNT + s * 4096; E.nmini = 88;
            pg8::gemm_phase<EpiRes<true>, pg8::TailOrder>(lds, g, S, E);
        }
        if (blk >= G - 64) {
            CP p = kp(); const int tid = tid_(), lane = tid & 63, wave = __builtin_amdgcn_readfirstlane(tid >> 6);
            unsigned* sc = (unsigned*)p->ws + CW_CNT + s * 4096 + 32;
            if (wave == 0) { unsigned sp = 0; while ((unsigned)__builtin_amdgcn_readfirstlane(__hip_atomic_load(sc, __ATOMIC_RELAXED, __HIP_MEMORY_SCOPE_AGENT)) < (unsigned)G) { __builtin_amdgcn_s_sleep(1); if (++sp > (1u << 22)) break; }
                __builtin_amdgcn_fence(__ATOMIC_ACQUIRE, "agent"); asm volatile("s_waitcnt vmcnt(0)" ::: "memory"); }
            __syncthreads();
            const float* gp = (half ? p->in[12] : p->in[8]) + l * D; const float* bp = (half ? p->in[13] : p->in[9]) + l * D;
            const int m = TP + (blk - (G - 64)) * 8 + wave;
            ln_row<11>(s == 3 ? p->out + O_Y + (size_t)m * D : nullptr, (bf16_t*)WSP(p, WS_XB) + (size_t)m * D, gp, bp, lane, (const float*)WSP(p, WS_ACUM) + (size_t)(m - TP) * D);
        }
        if (s == 3) break;
        GRID_SYNC();
        if (half) continue;

        {
            CP p = kp(); unsigned char* wl = WSP(p, WS_W + (size_t)l * WL_SIZE);
            pg8::Gemm g{(const bf16_t*)WSP(p, WS_XB), (const bf16_t*)(wl + WL_IN), T, NIN, D}; pg8::StaticOrder S; S.init(T, NIN, D, G, blk);
            EpiZ E{(bf16_t*)WSP(p, WS_HZ)};
            pg8::gemm_phase<EpiZ, pg8::StaticOrder>(lds, g, S, E);
        }
        GRID_SYNC();
#pragma unroll 1
        for (int slot = 0; slot < 4; ++slot) {
            const int cat = (slot + ((blk & 1) << 1)) & 3;
            if (cat == 0) {
                for (int it = blk; it < 256; it += G) { CP p = kp();
                    attn_prompt_item(lds, (const bf16_t*)WSP(p, WS_HZ), (const bf16_t*)WSP(p, WS_KMEM) + (size_t)l * 2048 * 512, (const bf16_t*)WSP(p, WS_VT) + (size_t)l * 512 * 2048,
                                     (bf16_t*)WSP(p, WS_YBR) + 2 * CW, it, tid_()); }
            } else if (cat == 1) {
                for (int it = blk; it < 512; it += G) { CP p = kp();
                    attn_sample_item(lds, (const bf16_t*)WSP(p, WS_HZ), p->in[2] + (size_t)l * 128 * 256 * 512, p->in[3] + (size_t)l * 128 * 256 * 512,
                                     (bf16_t*)WSP(p, WS_YBR) + 2 * CW, it, tid_()); }
            } else if (cat == 2) {
                ZRows zcur;
                { CP p = kp(); zcur = lru_zload((const bf16_t*)WSP(p, WS_HZ), blk < 1056 ? blk : 0, tid_()); }
                for (int it = blk; it < 1056; it += G) { CP p = kp(); unsigned char* wl = WSP(p, WS_W + (size_t)l * WL_SIZE);
                    const ZRows znext = lru_zload((const bf16_t*)WSP(p, WS_HZ), it + G < 1056 ? it + G : it, tid_());
                    lru_item(lds, p, l, (const bf16_t*)WSP(p, WS_HZ), (const bf16_t*)(wl + WL_LWA), (const bf16_t*)(wl + WL_LWX),
                             (float*)WSP(p, WS_ACUM), (float*)WSP(p, WS_BCUM), (float*)WSP(p, WS_AGG), (bf16_t*)WSP(p, WS_YBR) + CW, it, tid_(), zcur, it == blk || (G & 7) != 0);
                    zcur = znext; }
            } else {
                for (int it = (G > 64 ? blk - 32 : blk); it >= 0 && it < 528; it += (G > 64 ? G - 32 : G)) { CP p = kp();
                    conv_item(p, l, (const bf16_t*)WSP(p, WS_HZ), (bf16_t*)WSP(p, WS_YBR), it, tid_()); }
            }
        }
        GRID_SYNC();
#pragma unroll 1
        for (int ph = 0; ph < 2; ++ph) {
            if (ph == 0) {
                for (int it = blk; it < 128; it += G) { CP p = kp();
                    lru_apply_item(p, l, (const bf16_t*)WSP(p, WS_HZ), (const float*)WSP(p, WS_ACUM), (const float*)WSP(p, WS_BCUM), (const float*)WSP(p, WS_AGG),
                                   (bf16_t*)WSP(p, WS_YBR) + CW, it, tid_()); }
            }
            if (ph == 1 && blk >= G - 64) {
                CP p = kp(); const int tid = tid_(), lane = tid & 63, wave = __builtin_amdgcn_readfirstlane(tid >> 6);
                const int m = (blk - (G - 64)) * 8 + wave;
                const float* sb = (const float*)WSP(p, WS_SLB3) + (size_t)m * D; bf16_t* mo = (bf16_t*)WSP(p, WS_MRG) + (size_t)(TP + m) * D;
#pragma unroll
                for (int j = 0; j < 4; ++j) { const f32x4 v = *((const f32x4*)sb + lane + 64 * j) + *((const f32x4*)(sb + (size_t)TS * D) + lane + 64 * j) + *((const f32x4*)(sb + 2 * (size_t)TS * D) + lane + 64 * j);
                    u32x2 w; w.x = cvt_pk_bf16(v[0], v[1]); w.y = cvt_pk_bf16(v[2], v[3]); *((u32x2*)mo + lane + 64 * j) = w; }
            }
            if (ph == 0 && blk >= G - 24) {
                CP p = kp(); unsigned char* wl = WSP(p, WS_W + (size_t)l * WL_SIZE);
                pg8::Gemm g{(const bf16_t*)WSP(p, WS_YBR), (const bf16_t*)(wl + WL_BR), T, D, 3 * CW}; pg8::ChainOrder S; S.init(TP, D, 3 * CW, G, blk, __builtin_amdgcn_readfirstlane(blk - (G - 24)));
                EpiBrS E{(float*)WSP(p, WS_SLB3), (const bf16_t*)WSP(p, WS_HZ) + ZC_GL};
                pg8::gemm_phase<EpiBrS, pg8::ChainOrder>(lds, g, S, E);
            }
            if (ph == 1) {
                CP p = kp(); unsigned char* wl = WSP(p, WS_W + (size_t)l * WL_SIZE);
                pg8::Gemm g{(const bf16_t*)WSP(p, WS_YBR), (const bf16_t*)(wl + WL_BR), T, D, 3 * CW}; pg8::ChainOrder S; S.init(TP, D, 3 * CW, G, blk, -1);
                EpiBr E{(bf16_t*)WSP(p, WS_MRG), (const bf16_t*)WSP(p, WS_HZ) + ZC_GL};
                pg8::gemm_phase<EpiBr, pg8::ChainOrder>(lds, g, S, E);
            }
            GRID_SYNC();
        }
        {
            CP p = kp(); unsigned char* wl = WSP(p, WS_W + (size_t)l * WL_SIZE);
            pg8::Gemm g{(const bf16_t*)WSP(p, WS_MRG), (const bf16_t*)(wl + WL_O), T, D, D}; pg8::TailOrder S; S.init(D, D, G, blk, 4);
            EpiRes<false> E; E.Xout = nullptr; E.slab = (float*)WSP(p, WS_ACUM);
            E.lng = p->in[10] + l * D; E.lnb = p->in[11] + l * D; E.cnt = (unsigned*)p->ws + CW_CNT + (4 + l) * 4096; E.nmini = 32;
            pg8::gemm_phase<EpiRes<false>, pg8::TailOrder>(lds, g, S, E);
        }
        if (blk >= G - 64) {
            CP p = kp(); const int tid = tid_(), lane = tid & 63, wave = __builtin_amdgcn_readfirstlane(tid >> 6);
            unsigned* sc = (unsigned*)p->ws + CW_CNT + (4 + l) * 4096 + 32;
            if (wave == 0) { unsigned sp = 0; while ((unsigned)__builtin_amdgcn_readfirstlane(__hip_atomic_load(sc, __ATOMIC_RELAXED, __HIP_MEMORY_SCOPE_AGENT)) < (unsigned)G) { __builtin_amdgcn_s_sleep(1); if (++sp > (1u << 22)) break; }
                __builtin_amdgcn_fence(__ATOMIC_ACQUIRE, "agent"); asm volatile("s_waitcnt vmcnt(0)" ::: "memory"); }
            __syncthreads();
            const int m = TP + (blk - (G - 64)) * 8 + wave;
            ln_row<4>(nullptr, (bf16_t*)WSP(p, WS_XB) + (size_t)m * D, p->in[10] + l * D, p->in[11] + l * D, lane, (const float*)WSP(p, WS_ACUM) + (size_t)(m - TP) * D);
        }
        GRID_SYNC();
    }
}

extern "C" void kernel_launch(void* const* d_in, const int* in_sizes, int n_in, void* d_out, int out_size, void* d_ws, size_t ws_size, hipStream_t stream) {
    static int grid_blocks = 0;
    if (!grid_blocks) {
        int dev = 0, cus = 0, per_cu = 0;
        (void)hipGetDevice(&dev);
        (void)hipDeviceGetAttribute(&cus, hipDeviceAttributeMultiprocessorCount, dev);
        (void)hipFuncSetAttribute((const void*)mega, hipFuncAttributeMaxDynamicSharedMemorySize, LDS_BYTES);
        (void)hipOccupancyMaxActiveBlocksPerMultiprocessor(&per_cu, (const void*)mega, 512, LDS_BYTES);
        if (per_cu < 1) per_cu = 1;
        grid_blocks = cus * per_cu;
        if (ws_size < WS_END) fprintf(stderr, "kernel_launch: workspace too small: %zu < %zu\n", ws_size, (size_t)WS_END);
    }
    Params p{};
    for (int i = 0; i < 35; ++i) p.in[i] = (const float*)d_in[i];
    p.out = (float*)d_out; p.ws = (unsigned char*)d_ws;
    void* args[] = {&p};
    (void)hipMemsetAsync(d_ws, 0, (size_t)CW_WORDS * 4, stream);
    hipError_t e = hipLaunchCooperativeKernel((const void*)mega, dim3(grid_blocks), dim3(512), args, LDS_BYTES, stream);
    if (e != hipSuccess) fprintf(stderr, "cooperative launch failed: %s (grid %d)\n", hipGetErrorString(e), grid_blocks);
}
```
